# Optimizing an MI355X kernel written in HIP

```python
import jax, jax.numpy as jnp
from jax import lax
import numpy as np

D_MODEL = 2048
BATCH = 4
SEQ = 4096
DEPTH = 2

C_A = D_MODEL // 2
N_FGROUPS = 4
F_GROUP = C_A // N_FGROUPS
C_B = D_MODEL // 2
N_B = 64
H_B = C_B // N_B
R_DECAY = 64
R_ICLR = 64
R_GATE = 160
IN_B = 3 * C_B + 2 * R_DECAY + 2 * R_ICLR + R_GATE
IN_AB = C_A + IN_B
GN_EPS = 6.4e-4
DSA_HEAD_DIM = 128
DSA_HEADS = D_MODEL // DSA_HEAD_DIM
DSA_PATTERNS = ((128, 1), (512, 4), (2048, 16))
NEG_INF = -1e30
N_EXPERTS = 64
TOP_K = 8
N_GROUPS = 8
TOPK_GROUPS = 4
D_EXPERT = D_MODEL // 4
ROUTED_SCALE = 2.5
EXPERT_BLOCK = 128
LN_EPS = 1e-5
ALPHA = (2 * DEPTH) ** 0.25
BETA = (8 * DEPTH) ** -0.25
ADA_SCALE = 0.25

kernel_name = 'hybrid_fourier_rwkv7_dilated_moe_encoder'


def layer_norm(x, g, b):
    xf = x.astype(jnp.float32)
    mu = jnp.mean(xf, -1, keepdims=True)
    var = jnp.mean(jnp.square(xf - mu), -1, keepdims=True)
    return ((xf - mu) * lax.rsqrt(var + LN_EPS) * g + b).astype(x.dtype)


def ada_modulation(c, w, b):
    m = (jax.nn.silu(c) @ w + b)[:, None, :]
    shift, scale, gate = jnp.split(m, 3, axis=-1)
    return shift, scale, gate


def fourier_mix(p):
    Bsz, T, _ = p.shape
    z = p.astype(jnp.float32).reshape(Bsz, T, N_FGROUPS, F_GROUP)
    f = jnp.fft.fft2(z, axes=(1, 3), norm='ortho').real
    return f.reshape(Bsz, T, C_A)


def _wkv_step(S, inp):
    r_t, w_t, k_t, v_t, a_t, b_t = inp
    sa = jnp.einsum('bzhij,bzhj->bzhi', S, a_t)
    S = S * w_t[..., None, :] + sa[..., :, None] * b_t[..., None, :] + v_t[..., :, None] * k_t[..., None, :]
    y = jnp.einsum('bzhij,bzhj->bzhi', S, r_t)
    return S, y


def rwkv7_bidirectional(p, mu_prev, mu_next, w0, w_up, a0, a_up, g_up, k_k, k_a, r_k, lnx_g, lnx_b):
    Bsz, T, _ = p.shape
    f32 = jnp.float32
    p = p.astype(f32)
    prev = jnp.pad(p, ((0, 0), (1, 0), (0, 0)))[:, :-1]
    nxt = jnp.pad(p, ((0, 0), (0, 1), (0, 0)))[:, 1:]
    p = p + mu_prev * (prev - p) + mu_next * (nxt - p)
    cuts = np.cumsum([C_B, C_B, C_B, 2 * R_DECAY, 2 * R_ICLR]).tolist()
    r, k, v, wd, ad, gd = jnp.split(p, cuts, axis=-1)
    wd = wd.reshape(Bsz, T, 2, R_DECAY)
    ad = ad.reshape(Bsz, T, 2, R_ICLR)
    w_raw = w0 + jnp.einsum('btzr,zrc->btzc', jnp.tanh(wd), w_up)
    log_w = -jax.nn.softplus(-w_raw) - 0.5
    decay = jnp.exp(-jnp.exp(log_w))
    iclr = jax.nn.sigmoid(a0 + jnp.einsum('btzr,zrc->btzc', ad, a_up))
    g = jax.nn.sigmoid(gd) @ g_up
    hd = lambda z: z.reshape(z.shape[:-1] + (H_B, N_B))
    kk = hd(k * k_k)
    kk = kk / jnp.maximum(jnp.sqrt(jnp.sum(kk * kk, -1, keepdims=True)), 1e-12)
    r, k, v = hd(r), hd(k), hd(v)
    decay, iclr = hd(decay), hd(iclr)
    k_dir = k[:, :, None] * (1.0 + (iclr - 1.0) * hd(k_a))
    b_dir = kk[:, :, None] * iclr
    a_dir = jnp.broadcast_to(-kk[:, :, None], decay.shape)
    r_dir = jnp.broadcast_to(r[:, :, None], decay.shape)
    v_dir = jnp.broadcast_to(v[:, :, None], decay.shape)
    bonus = jnp.sum(jnp.sum(r[:, :, None] * k_dir * r_k, -1, keepdims=True) * v[:, :, None], axis=2)

    def orient(z):
        return jnp.moveaxis(jnp.stack([z[:, :, 0], z[:, ::-1, 1]], axis=2), 1, 0)

    xs = tuple(orient(z) for z in (r_dir, decay, k_dir, v_dir, a_dir, b_dir))
    S0 = jnp.zeros((Bsz, 2, H_B, N_B, N_B), f32)
    _, ys = lax.scan(_wkv_step, S0, xs)
    ys = jnp.moveaxis(ys, 0, 1)
    y = ys[:, :, 0] + ys[:, ::-1, 1]
    mu = jnp.mean(y, -1, keepdims=True)
    var = jnp.mean(jnp.square(y - mu), -1, keepdims=True)
    y = ((y - mu) * lax.rsqrt(var + GN_EPS)).reshape(Bsz, T, C_B) * lnx_g + lnx_b
    return (y + bonus.reshape(Bsz, T, C_B)) * g


def fourier_rwkv_mixer(u, w_in, mu_prev, mu_next, w0, w_up, a0, a_up, g_up, k_k, k_a, r_k, lnx_g, lnx_b, w_out):
    proj = u @ w_in
    ya = fourier_mix(proj[..., :C_A])
    yb = rwkv7_bidirectional(proj[..., C_A:], mu_prev, mu_next, w0, w_up, a0, a_up, g_up,
                             k_k, k_a, r_k, lnx_g, lnx_b)
    y = jnp.concatenate([ya, yb], axis=-1).astype(u.dtype)
    return y @ w_out


def dilated_branch(q, k, v, window, dil, slopes):
    Bsz, T, H, hdim = q.shape
    side = window // (2 * dil)
    blk = side
    L = T // dil
    nb = -(-L // blk)
    Lp = nb * blk

    def by_residue(z):
        return jnp.swapaxes(z.reshape(Bsz, L, dil, H, hdim), 1, 2)

    qr, kr, vr = by_residue(q), by_residue(k), by_residue(v)
    qb = jnp.pad(qr, ((0, 0), (0, 0), (0, Lp - L), (0, 0), (0, 0))).reshape(Bsz, dil, nb, blk, H, hdim)

    def band(z):
        zp = jnp.pad(z, ((0, 0), (0, 0), (blk, Lp - L + blk), (0, 0), (0, 0))).reshape(Bsz, dil, nb + 2, blk, H, hdim)
        return jnp.concatenate([zp[:, :, :nb], zp[:, :, 1:nb + 1], zp[:, :, 2:]], axis=3)

    kw, vw = band(kr), band(vr)
    q_idx = jnp.arange(nb)[:, None] * blk + jnp.arange(blk)[None, :]
    k_idx = jnp.arange(nb)[:, None] * blk - blk + jnp.arange(3 * blk)[None, :]
    rel = jnp.abs(k_idx[:, None, :] - q_idx[:, :, None])
    valid = (rel <= side) & (k_idx[:, None, :] >= 0) & (k_idx[:, None, :] < L)
    s = jnp.einsum('brnihc,brnjhc->brnhij', qb, kw)
    s = s - slopes[:, None, None] * (dil * rel).astype(jnp.float32)[:, None]
    s = jnp.where(valid[:, None], s, NEG_INF)
    m = jnp.max(s, -1)
    p = jnp.exp(s - m[..., None])
    den = jnp.sum(p, -1)
    o = jnp.einsum('brnhij,brnjhc->brnihc', p, vw)

    def from_residue(z):
        return jnp.swapaxes(z[:, :, :L], 1, 2).reshape((Bsz, T) + z.shape[3:])

    o = from_residue(o.reshape(Bsz, dil, Lp, H, hdim))
    m = from_residue(jnp.swapaxes(m, 3, 4).reshape(Bsz, dil, Lp, H))
    den = from_residue(jnp.swapaxes(den, 3, 4).reshape(Bsz, dil, Lp, H))
    return o, m, den


def dilated_attention_mixer(u, w_qkv, w_out):
    Bsz, T, _ = u.shape
    q, k, v = jnp.split((u @ w_qkv).astype(jnp.float32), 3, axis=-1)
    q, k, v = (z.reshape(Bsz, T, DSA_HEADS, DSA_HEAD_DIM) for z in (q, k, v))
    q = q * DSA_HEAD_DIM ** -0.5
    slopes = 2.0 ** (-8.0 * jnp.arange(1, DSA_HEADS + 1, dtype=jnp.float32) / DSA_HEADS)
    outs, maxes, dens = zip(*[dilated_branch(q, k, v, w, d, slopes) for (w, d) in DSA_PATTERNS])
    m = jnp.stack(maxes)
    wts = jnp.exp(m - jnp.max(m, 0))
    num = jnp.einsum('gbth,gbthc->bthc', wts, jnp.stack(outs))
    den = jnp.sum(wts * jnp.stack(dens), 0)
    o = num / den[..., None]
    return o.reshape(Bsz, T, D_MODEL).astype(u.dtype) @ w_out


def swiglu(x, wg, wu, wd):
    return (jax.nn.silu(x @ wg) * (x @ wu)) @ wd


def route(xf, w_router, b_router):
    N = xf.shape[0]
    scores = jax.nn.sigmoid((xf @ w_router).astype(jnp.float32))
    biased = scores + b_router.astype(jnp.float32)
    grp = biased.reshape(N, N_GROUPS, N_EXPERTS // N_GROUPS)
    grp_score = jnp.sum(lax.top_k(grp, 2)[0], -1)
    _, gidx = lax.top_k(grp_score, TOPK_GROUPS)
    gmask = jnp.any(gidx[:, :, None] == jnp.arange(N_GROUPS)[None, None, :], axis=1)
    emask = jnp.repeat(gmask, N_EXPERTS // N_GROUPS, axis=1)
    _, idx = lax.top_k(jnp.where(emask, biased, -jnp.inf), TOP_K)
    w = jnp.take_along_axis(scores, idx, axis=1)
    w = w / jnp.sum(w, -1, keepdims=True) * ROUTED_SCALE
    return idx, w.astype(xf.dtype)


def routed_experts(xf, idx, gate_w, w_gate, w_up, w_down):
    N, D = xf.shape
    M = N * TOP_K
    e_flat = idx.reshape(M)
    tok_flat = jnp.arange(M, dtype=jnp.int32) // TOP_K
    g_flat = gate_w.reshape(M)
    order = jnp.argsort(e_flat)
    e_sorted, tok_sorted, g_sorted = e_flat[order], tok_flat[order], g_flat[order]
    counts = jnp.bincount(e_flat, length=N_EXPERTS)
    starts = jnp.cumsum(counts) - counts
    padded = (counts + EXPERT_BLOCK - 1) // EXPERT_BLOCK * EXPERT_BLOCK
    pends = jnp.cumsum(padded)
    pstarts = pends - padded
    dest = pstarts[e_sorted] + (jnp.arange(M) - starts[e_sorted])
    NB = -(-M // EXPERT_BLOCK) + N_EXPERTS
    P = NB * EXPERT_BLOCK
    buf_tok = jnp.full((P,), N, jnp.int32).at[dest].set(tok_sorted)
    buf_g = jnp.zeros((P,), xf.dtype).at[dest].set(g_sorted)
    block_e = jnp.minimum(jnp.searchsorted(pends, jnp.arange(NB) * EXPERT_BLOCK, side='right'),
                          N_EXPERTS - 1).astype(jnp.int32)
    x_pad = jnp.concatenate([xf, jnp.zeros((1, D), xf.dtype)], axis=0)

    def body(acc, blk):
        tok, g, e = blk
        xb = x_pad[tok]
        h = jax.nn.silu(xb @ w_gate[e]) * (xb @ w_up[e])
        y = (h @ w_down[e]) * g[:, None]
        return acc.at[tok].add(y), None

    acc, _ = lax.scan(body, jnp.zeros((N + 1, D), xf.dtype),
                      (buf_tok.reshape(NB, EXPERT_BLOCK), buf_g.reshape(NB, EXPERT_BLOCK), block_e))
    return acc[:N]


def moe_ffn(u, w_router, b_router, w_gate, w_up, w_down, s_gate, s_up, s_down):
    Bsz, T, D = u.shape
    xf = u.reshape(Bsz * T, D)
    idx, w = route(xf, w_router, b_router)
    y = routed_experts(xf, idx, w, w_gate, w_up, w_down) + swiglu(xf, s_gate, s_up, s_down)
    return y.reshape(Bsz, T, D)


def setup_inputs(seed: int = 0) -> dict:
    key = jax.random.key(seed)
    ks = iter(jax.random.split(key, 48))
    nrm = lambda shape, scale: jax.random.normal(next(ks), shape, jnp.float32) * scale
    uni = lambda shape: jax.random.uniform(next(ks), shape, jnp.float32, 0.0, 0.5)
    NE = (DEPTH + 1) // 2
    NO = DEPTH // 2
    L = DEPTH
    D = D_MODEL
    return {
        'x': nrm((BATCH, SEQ, D), 1.0),
        'c': nrm((BATCH, D), 1.0),
        'ab_w_in': nrm((NE, D, IN_AB), D ** -0.5),
        'ab_mu_prev': uni((NE, IN_B)),
        'ab_mu_next': uni((NE, IN_B)),
        'ab_w0': -2.0 + nrm((NE, 2, C_B), 1.0),
        'ab_w_up': nrm((NE, 2, R_DECAY, C_B), 0.5 * R_DECAY ** -0.5),
        'ab_a0': nrm((NE, 2, C_B), 0.5),
        'ab_a_up': nrm((NE, 2, R_ICLR, C_B), 0.5 * R_ICLR ** -0.5),
        'ab_g_up': nrm((NE, R_GATE, C_B), R_GATE ** -0.5),
        'ab_k_k': 1.0 + nrm((NE, C_B), 0.1),
        'ab_k_a': 1.0 + nrm((NE, C_B), 0.1),
        'ab_r_k': nrm((NE, H_B, N_B), 0.1),
        'ab_lnx_g': 1.0 + nrm((NE, C_B), 0.05),
        'ab_lnx_b': nrm((NE, C_B), 0.02),
        'ab_w_out': nrm((NE, C_A + C_B, D), (C_A + C_B) ** -0.5 * BETA),
        'dsa_w_qkv': nrm((NO, D, 3 * D), D ** -0.5),
        'dsa_w_out': nrm((NO, D, D), D ** -0.5 * BETA),
        'ada_mix_w': nrm((L, D, 3 * D), ADA_SCALE * D ** -0.5),
        'ada_mix_b': nrm((L, 3 * D), 0.02),
        'ln_mix_g': 1.0 + nrm((L, D), 0.05),
        'ln_mix_b': nrm((L, D), 0.02),
        'ada_ffn_w': nrm((L, D, 3 * D), ADA_SCALE * D ** -0.5),
        'ada_ffn_b': nrm((L, 3 * D), 0.02),
        'ln_ffn_g': 1.0 + nrm((L, D), 0.05),
        'ln_ffn_b': nrm((L, D), 0.02),
        'router_w': nrm((L, D, N_EXPERTS), D ** -0.5),
        'router_b': nrm((L, N_EXPERTS), 0.01),
        'exp_gate': nrm((L, N_EXPERTS, D, D_EXPERT), D ** -0.5),
        'exp_up': nrm((L, N_EXPERTS, D, D_EXPERT), D ** -0.5),
        'exp_down': nrm((L, N_EXPERTS, D_EXPERT, D), D_EXPERT ** -0.5 * BETA),
        'sh_gate': nrm((L, D, D_EXPERT), D ** -0.5),
        'sh_up': nrm((L, D, D_EXPERT), D ** -0.5),
        'sh_down': nrm((L, D_EXPERT, D), D_EXPERT ** -0.5 * BETA),
    }


def reference(x, c, ab_w_in, ab_mu_prev, ab_mu_next, ab_w0, ab_w_up, ab_a0, ab_a_up, ab_g_up,
              ab_k_k, ab_k_a, ab_r_k, ab_lnx_g, ab_lnx_b, ab_w_out, dsa_w_qkv, dsa_w_out,
              ada_mix_w, ada_mix_b, ln_mix_g, ln_mix_b, ada_ffn_w, ada_ffn_b, ln_ffn_g, ln_ffn_b,
              router_w, router_b, exp_gate, exp_up, exp_down, sh_gate, sh_up, sh_down):
    for layer in range(DEPTH):
        i = layer // 2
        shift, scale, gate = ada_modulation(c, ada_mix_w[layer], ada_mix_b[layer])
        u = x * (1.0 + scale) + shift
        if layer % 2 == 0:
            h = fourier_rwkv_mixer(u, ab_w_in[i], ab_mu_prev[i], ab_mu_next[i], ab_w0[i], ab_w_up[i],
                                   ab_a0[i], ab_a_up[i], ab_g_up[i], ab_k_k[i], ab_k_a[i], ab_r_k[i],
                                   ab_lnx_g[i], ab_lnx_b[i], ab_w_out[i])
        else:
            h = dilated_attention_mixer(u, dsa_w_qkv[i], dsa_w_out[i])
        x = layer_norm(ALPHA * x + (1.0 + gate) * h, ln_mix_g[layer], ln_mix_b[layer])
        shift, scale, gate = ada_modulation(c, ada_ffn_w[layer], ada_ffn_b[layer])
        u = x * (1.0 + scale) + shift
        h = moe_ffn(u, router_w[layer], router_b[layer], exp_gate[layer], exp_up[layer], exp_down[layer],
                    sh_gate[layer], sh_up[layer], sh_down[layer])
        x = layer_norm(ALPHA * x + (1.0 + gate) * h, ln_ffn_g[layer], ln_ffn_b[layer])
    return x
```

```cpp
#include <hip/hip_runtime.h>
#include <stdint.h>
#include <stdio.h>

#ifndef DBG_ZERO
#define DBG_ZERO 0
#endif
#ifndef DBG_NAIVE_ATTN
#define DBG_NAIVE_ATTN 0
#endif
#ifndef GEMM_FAST
#define GEMM_FAST 1
#endif
#ifndef DBG_REPEAT_MASK
#define DBG_REPEAT_MASK 0
#endif
#ifndef DBG_DRY
#define DBG_DRY 0
#endif
#ifndef MOE2_STAGGER
#define MOE2_STAGGER 0
#endif
#ifndef CONV_IN_SCAN
#define CONV_IN_SCAN 1
#endif
#ifndef MK_MULTI
#define MK_MULTI 0
#endif

typedef unsigned short bf16_t;
typedef short bf16x8 __attribute__((ext_vector_type(8)));
typedef float f32x4 __attribute__((ext_vector_type(4)));
typedef float f32x2 __attribute__((ext_vector_type(2)));
typedef unsigned u32x4 __attribute__((ext_vector_type(4)));
typedef unsigned u32x2 __attribute__((ext_vector_type(2)));
#define DEV __device__ __forceinline__
#define LAS __attribute__((address_space(3)))

constexpr int NTOK = 16384, DM = 2048, SEQ = 4096, NBATCH = 4;
constexpr int INP = 4608;
constexpr int IN_AB = 4512, IN_B = 3488;
constexpr int NEXP = 64, DEXP = 512;
constexpr int RMAX = 131072 + 64 * 256 + 16384;
constexpr int NTHREADS = 512;
constexpr int LDS_BYTES = 160 * 1024;
constexpr float ALPHA = 1.41421356237f;

struct Params {
    const float *x, *c, *ab_w_in, *ab_mu_prev, *ab_mu_next, *ab_w0, *ab_w_up, *ab_a0, *ab_a_up, *ab_g_up, *ab_k_k, *ab_k_a, *ab_r_k,
        *ab_lnx_g, *ab_lnx_b, *ab_w_out, *dsa_w_qkv, *dsa_w_out, *ada_mix_w, *ada_mix_b, *ln_mix_g, *ln_mix_b, *ada_ffn_w, *ada_ffn_b,
        *ln_ffn_g, *ln_ffn_b, *router_w, *router_b, *exp_gate, *exp_up, *exp_down, *sh_gate, *sh_up, *sh_down;
    float* out;
    unsigned* bar;
    int* gcnt;
    int* blockbase;
    int* meta;
    int* tile_e;
    int *sel_e, *sel_pos; float* sel_w;
    int *row_src, *row_dst; float* row_g;
    u32x2* row_rec;
    float* mod;
    bf16_t *wt_in, *wt_out0, *wt_qkv, *wt_o1, *w2, *wl_wa, *wl_g, *dft1, *dft2;
    unsigned char* w1;
    unsigned char* U8;
    bf16_t* U;
    bf16_t* X;
    bf16_t* T;
    bf16_t* H;
    bf16_t *proj, *wtf, *zf, *pq, *R, *K, *V, *KK, *alora, *omw, *iclr, *G, *ycat;
    float* wn;
    bf16_t* Y;
    bf16_t *qkv, *op, *ocat; float* lse;
    unsigned char* slot;
};

DEV float bf2f(bf16_t v) { return __uint_as_float((unsigned)v << 16); }
typedef __bf16 bf16x2_t __attribute__((ext_vector_type(2)));
DEV unsigned cvt_pk_bf16(float lo, float hi) { const f32x2 v = {lo, hi}; return __builtin_bit_cast(unsigned, __builtin_convertvector(v, bf16x2_t)); }
DEV unsigned pack4_fp8(float a, float b, float c, float d) {
    int v = __builtin_amdgcn_cvt_pk_fp8_f32(a, b, 0, false); return (unsigned)__builtin_amdgcn_cvt_pk_fp8_f32(c, d, v, true);
}
DEV bf16_t f2bf(float x) { return (bf16_t)(cvt_pk_bf16(x, 0.f) & 0xffffu); }
DEV float bflo(unsigned w) { return __uint_as_float(w << 16); }
DEV float bfhi(unsigned w) { return __uint_as_float(w & 0xffff0000u); }
DEV void unpack8(const u32x4 w, float (&f)[8]) { f[0] = bflo(w.x); f[1] = bfhi(w.x); f[2] = bflo(w.y); f[3] = bfhi(w.y); f[4] = bflo(w.z); f[5] = bfhi(w.z); f[6] = bflo(w.w); f[7] = bfhi(w.w); }
DEV u32x4 pack8(const float (&f)[8]) { u32x4 w; w.x = cvt_pk_bf16(f[0], f[1]); w.y = cvt_pk_bf16(f[2], f[3]); w.z = cvt_pk_bf16(f[4], f[5]); w.w = cvt_pk_bf16(f[6], f[7]); return w; }
DEV int opaque_lane() { unsigned z = 0u; asm volatile("" : "+s"(z)); return (int)__builtin_amdgcn_mbcnt_hi(~0u, __builtin_amdgcn_mbcnt_lo(~0u, z)); }
DEV float shfl_xor_l(float v, int o, int l) { return __builtin_bit_cast(float, __builtin_amdgcn_ds_bpermute((l ^ o) << 2, __builtin_bit_cast(int, v))); }
#define SHFLX(v, o) shfl_xor_l((v), (o), opaque_lane())
DEV float wave_sum(float v) {
    const int l = opaque_lane();
#pragma unroll
    for (int o = 32; o >= 1; o >>= 1) v += shfl_xor_l(v, o, l);
    return v;
}
DEV float wave_max(float v) {
    const int l = opaque_lane();
#pragma unroll
    for (int o = 32; o >= 1; o >>= 1) v = fmaxf(v, shfl_xor_l(v, o, l));
    return v;
}
template <int CTRL> DEV float dpp_mov(float x) { return __builtin_bit_cast(float, __builtin_amdgcn_update_dpp(0, __builtin_bit_cast(int, x), CTRL, 0xF, 0xF, true)); }
DEV float dpp_sum16(float x) { x += dpp_mov<0xB1>(x); x += dpp_mov<0x4E>(x); x += dpp_mov<0x141>(x); x += dpp_mov<0x140>(x); return x; }
DEV int opaque_tid(int wv) { unsigned z = 0u; asm volatile("" : "+s"(z)); int t = (wv << 6) | (int)__builtin_amdgcn_mbcnt_hi(~0u, __builtin_amdgcn_mbcnt_lo(~0u, z)); asm volatile("" : "+v"(t)); return t; }
DEV void dpp_sum16_pair(float& a, float& b) {
    asm volatile(
        "s_nop 1\n\t"
        "v_add_f32_dpp %0, %0, %0 quad_perm:[1,0,3,2] row_mask:0xf bank_mask:0xf bound_ctrl:1\n\t"
        "v_add_f32_dpp %1, %1, %1 quad_perm:[1,0,3,2] row_mask:0xf bank_mask:0xf bound_ctrl:1\n\t"
        "s_nop 0\n\t"
        "v_add_f32_dpp %0, %0, %0 quad_perm:[2,3,0,1] row_mask:0xf bank_mask:0xf bound_ctrl:1\n\t"
        "v_add_f32_dpp %1, %1, %1 quad_perm:[2,3,0,1] row_mask:0xf bank_mask:0xf bound_ctrl:1\n\t"
        "s_nop 0\n\t"
        "v_add_f32_dpp %0, %0, %0 row_half_mirror row_mask:0xf bank_mask:0xf bound_ctrl:1\n\t"
        "v_add_f32_dpp %1, %1, %1 row_half_mirror row_mask:0xf bank_mask:0xf bound_ctrl:1\n\t"
        "s_nop 0\n\t"
        "v_add_f32_dpp %0, %0, %0 row_mirror row_mask:0xf bank_mask:0xf bound_ctrl:1\n\t"
        "v_add_f32_dpp %1, %1, %1 row_mirror row_mask:0xf bank_mask:0xf bound_ctrl:1\n\t"
        "s_nop 1"
        : "+v"(a), "+v"(b));
}
DEV void dpp_sum16_quad(float& a, float& b, float& c, float& d, const f32x2 pa, const f32x2 pb, const f32x2 pc, const f32x2 pd) {
    asm volatile(
        "v_add_f32 %0, %4, %5\n\t"
        "v_add_f32 %1, %6, %7\n\t"
        "v_add_f32 %2, %8, %9\n\t"
        "v_add_f32 %3, %10, %11\n\t"
        "v_add_f32_dpp %0, %0, %0 quad_perm:[1,0,3,2] row_mask:0xf bank_mask:0xf bound_ctrl:1\n\t"
        "v_add_f32_dpp %1, %1, %1 quad_perm:[1,0,3,2] row_mask:0xf bank_mask:0xf bound_ctrl:1\n\t"
        "v_add_f32_dpp %2, %2, %2 quad_perm:[1,0,3,2] row_mask:0xf bank_mask:0xf bound_ctrl:1\n\t"
        "v_add_f32_dpp %3, %3, %3 quad_perm:[1,0,3,2] row_mask:0xf bank_mask:0xf bound_ctrl:1\n\t"
        "v_add_f32_dpp %0, %0, %0 quad_perm:[2,3,0,1] row_mask:0xf bank_mask:0xf bound_ctrl:1\n\t"
        "v_add_f32_dpp %1, %1, %1 quad_perm:[2,3,0,1] row_mask:0xf bank_mask:0xf bound_ctrl:1\n\t"
        "v_add_f32_dpp %2, %2, %2 quad_perm:[2,3,0,1] row_mask:0xf bank_mask:0xf bound_ctrl:1\n\t"
        "v_add_f32_dpp %3, %3, %3 quad_perm:[2,3,0,1] row_mask:0xf bank_mask:0xf bound_ctrl:1\n\t"
        "v_add_f32_dpp %0, %0, %0 row_half_mirror row_mask:0xf bank_mask:0xf bound_ctrl:1\n\t"
        "v_add_f32_dpp %1, %1, %1 row_half_mirror row_mask:0xf bank_mask:0xf bound_ctrl:1\n\t"
        "v_add_f32_dpp %2, %2, %2 row_half_mirror row_mask:0xf bank_mask:0xf bound_ctrl:1\n\t"
        "v_add_f32_dpp %3, %3, %3 row_half_mirror row_mask:0xf bank_mask:0xf bound_ctrl:1\n\t"
        "v_add_f32_dpp %0, %0, %0 row_mirror row_mask:0xf bank_mask:0xf bound_ctrl:1\n\t"
        "v_add_f32_dpp %1, %1, %1 row_mirror row_mask:0xf bank_mask:0xf bound_ctrl:1\n\t"
        "v_add_f32_dpp %2, %2, %2 row_mirror row_mask:0xf bank_mask:0xf bound_ctrl:1\n\t"
        "v_add_f32_dpp %3, %3, %3 row_mirror row_mask:0xf bank_mask:0xf bound_ctrl:1"
        : "=&v"(a), "=&v"(b), "=&v"(c), "=&v"(d)
        : "v"(pa.x), "v"(pa.y), "v"(pb.x), "v"(pb.y), "v"(pc.x), "v"(pc.y), "v"(pd.x), "v"(pd.y));
}
DEV float sigmoidf_(float x) { return __builtin_amdgcn_rcpf(1.0f + __expf(-x)); }
DEV float siluf_(float x) { return x * __builtin_amdgcn_rcpf(1.0f + __expf(-x)); }

#define XB_TMO      128
#define XB_XCNT(j)  (256  + 64 * (j))
#define XB_XSUB(j)  (1280 + 64 * (j))
#define XB_XGEN(j)  (2304 + 64 * (j))
#define XB_TOP      3328
#define XB_TOPGEN   3392
#define XCD_BAR_WORDS 3456
#define XB_SPIN_CAP (1u << 18)
__device__ __forceinline__ unsigned xb_ld(unsigned* p)              { return __hip_atomic_load(p, __ATOMIC_RELAXED, __HIP_MEMORY_SCOPE_AGENT); }
__device__ __forceinline__ unsigned xb_add(unsigned* p, unsigned v) { return __hip_atomic_fetch_add(p, v, __ATOMIC_RELAXED, __HIP_MEMORY_SCOPE_AGENT); }
__device__ __forceinline__ unsigned xb_xcc_id() { return (unsigned)__builtin_amdgcn_s_getreg((3 << 11) | 20) & 0xFu; }
#define XB_SPIN(cond, bar) do { unsigned _sp = 0; while (cond) { __builtin_amdgcn_s_sleep(1); \
    if ((++_sp & 255u) == 0u) { if (xb_ld(&(bar)[XB_TMO])) break; if (_sp > XB_SPIN_CAP) { atomicAdd(&(bar)[XB_TMO], 1u); break; } } } } while (0)
struct XcdBarrier { unsigned* bar; unsigned x; volatile LAS unsigned* st; };
__device__ __forceinline__ XcdBarrier xcd_barrier_post(unsigned* bar, volatile LAS unsigned* st) {
    XcdBarrier b; b.bar = bar; b.x = xb_xcc_id(); b.st = st;
    if (threadIdx.x == 0) (void)xb_add(&bar[XB_XCNT(b.x)], 1u);
    return b;
}
__device__ __forceinline__ void xcd_barrier_complete(unsigned* bar, unsigned x, unsigned& nloc, unsigned& nx) {
    const unsigned G = gridDim.x * gridDim.y * gridDim.z;
    unsigned sum, cnt, mine, sp = 0u;
    for (;;) {
        sum = 0u; cnt = 0u; mine = 0u;
#pragma unroll
        for (unsigned j = 0; j < 16; ++j) { const unsigned c = xb_ld(&bar[XB_XCNT(j)]); sum += c; cnt += (c > 0u) ? 1u : 0u; mine = (j == x) ? c : mine; }
        if (sum == G) break;
        __builtin_amdgcn_s_sleep(1);
        if ((++sp & 255u) == 0u) { if (xb_ld(&bar[XB_TMO])) break; if (sp > XB_SPIN_CAP) { atomicAdd(&bar[XB_TMO], 1u); break; } }
    }
    nloc = mine > 0u ? mine : 1u; nx = cnt > 0u ? cnt : 1u;
}
__device__ __forceinline__ void xcd_barrier(const XcdBarrier& b) {
    asm volatile("s_waitcnt vmcnt(0)" ::: "memory");
    __syncthreads();
    if (threadIdx.x == 0) {
        unsigned* bar = b.bar;
        __builtin_amdgcn_s_waitcnt(0);
        unsigned nloc = b.st[0], nx = b.st[1];
        if (nloc == 0u) { xcd_barrier_complete(bar, b.x, nloc, nx); b.st[0] = nloc; b.st[1] = nx; }
        const unsigned old = xb_add(&bar[XB_XSUB(b.x)], 1u);
        const unsigned gen = old / nloc;
        if (old + 1u == (gen + 1u) * nloc) {
            __builtin_amdgcn_fence(__ATOMIC_RELEASE, "agent");
            asm volatile("s_waitcnt vmcnt(0)" ::: "memory");
            const unsigned og = xb_add(&bar[XB_TOP], 1u);
            const unsigned tg = og / nx;
            if (og + 1u == (tg + 1u) * nx) xb_add(&bar[XB_TOPGEN], 1u);
            else XB_SPIN(xb_ld(&bar[XB_TOPGEN]) == tg, bar);
            __builtin_amdgcn_fence(__ATOMIC_ACQUIRE, "agent");
            xb_add(&bar[XB_XGEN(b.x)], 1u);
            asm volatile("s_waitcnt vmcnt(0)" ::: "memory");
        } else {
            XB_SPIN(xb_ld(&bar[XB_XGEN(b.x)]) == gen, bar);
            __builtin_amdgcn_fence(__ATOMIC_ACQUIRE, "agent");
            asm volatile("s_waitcnt vmcnt(0)" ::: "memory");
        }
    }
    __syncthreads();
}

struct Unit { const bf16_t* A; const int* arow; const bf16_t* Bt; int pm, pn, e; long ooff; const void* tab; int tsel; };
DEV int perm32(int rho) { const int n = rho >> 4, i = rho & 15; return 8 * (i >> 2) + 4 * n + (i & 3); }

template <class Epi>
DEV void gemm_tile_simple(const Unit& u, long lda, long ldb, int K, const Epi& E) {
    const int tid = threadIdx.x, wid = __builtin_amdgcn_readfirstlane(tid >> 6), lane = tid & 63, wr = wid >> 2, wc = wid & 3, fr = lane & 15, fq = lane >> 4;
    f32x4 acc[2][2][4][2];
#pragma unroll
    for (int a = 0; a < 2; ++a)
#pragma unroll
        for (int b = 0; b < 2; ++b)
#pragma unroll
            for (int m = 0; m < 4; ++m)
#pragma unroll
                for (int n = 0; n < 2; ++n) acc[a][b][m][n] = (f32x4){0.f, 0.f, 0.f, 0.f};
    unsigned ao[2][4];
#pragma unroll
    for (int ai = 0; ai < 2; ++ai)
#pragma unroll
        for (int m = 0; m < 4; ++m) {
            const int r = 128 * ai + 64 * wr + 16 * m + fr;
            ao[ai][m] = (unsigned)((u.arow ? (long)u.arow[r] : (long)r) * lda + 8 * fq);
        }
    unsigned bo[2][2];
#pragma unroll
    for (int bj = 0; bj < 2; ++bj)
#pragma unroll
        for (int n = 0; n < 2; ++n) {
            const int rr = Epi::PERM ? perm32(16 * n + fr) : (16 * n + fr);
            bo[bj][n] = (unsigned)((long)(128 * bj + 32 * wc + rr) * ldb + 8 * fq);
        }
#pragma unroll 1
    for (int k0 = 0; k0 < K; k0 += 32) {
        bf16x8 af[2][4], bfr[2][2];
#pragma unroll
        for (int ai = 0; ai < 2; ++ai)
#pragma unroll
            for (int m = 0; m < 4; ++m) af[ai][m] = *(const bf16x8*)(u.A + k0 + ao[ai][m]);
#pragma unroll
        for (int bj = 0; bj < 2; ++bj)
#pragma unroll
            for (int n = 0; n < 2; ++n) bfr[bj][n] = *(const bf16x8*)(u.Bt + k0 + bo[bj][n]);
#pragma unroll
        for (int ai = 0; ai < 2; ++ai)
#pragma unroll
            for (int bj = 0; bj < 2; ++bj)
#pragma unroll
                for (int m = 0; m < 4; ++m)
#pragma unroll
                    for (int n = 0; n < 2; ++n) acc[ai][bj][m][n] = __builtin_amdgcn_mfma_f32_16x16x32_bf16(bfr[bj][n], af[ai][m], acc[ai][bj][m][n], 0, 0, 0);
    }
    E(acc, u, wr, wc, fr, fq);
}

struct EpiBf16 {
    static constexpr bool PERM = true; static constexpr int BMAP = 0;
    bf16_t* O; long ldo; int qcols; float qs;
    DEV void operator()(const f32x4 (&acc)[2][2][4][2], const Unit& u, int wr, int wc, int fr, int fq) const {
#pragma unroll
        for (int ai = 0; ai < 2; ++ai)
#pragma unroll
            for (int m = 0; m < 4; ++m) {
                bf16_t* rowp = O + u.ooff + (long)(128 * ai + 64 * wr + 16 * m + fr) * ldo + 32 * wc + 8 * fq;
#pragma unroll
                for (int bj = 0; bj < 2; ++bj) {
                    const float sc = (256 * u.pn < qcols) ? qs : 1.0f;
                    const f32x4 v0 = acc[ai][bj][m][0] * sc, v1 = acc[ai][bj][m][1] * sc;
                    u32x4 w; w.x = cvt_pk_bf16(v0[0], v0[1]); w.y = cvt_pk_bf16(v0[2], v0[3]); w.z = cvt_pk_bf16(v1[0], v1[1]); w.w = cvt_pk_bf16(v1[2], v1[3]);
                    *(u32x4*)(rowp + 128 * bj) = w;
                }
            }
    }
};
struct EpiLoraWA {
    static constexpr bool PERM = true; static constexpr int BMAP = 0;
    bf16_t *omw, *iclr; const float *w0, *a0;
    DEV void operator()(const f32x4 (&acc)[2][2][4][2], const Unit& u, int wr, int wc, int fr, int fq) const {
        const int colt = 256 * u.pn, type = colt >> 11, z = (colt >> 10) & 1;
        const float* bias = (type ? a0 : w0) + z * 1024;
        bf16_t* O = type ? iclr : omw;
        const int c0 = (colt & 1023) + 32 * wc + 8 * fq;
        f32x4 bv[2][2];
#pragma unroll
        for (int bj = 0; bj < 2; ++bj)
#pragma unroll
            for (int n = 0; n < 2; ++n) bv[bj][n] = *(const f32x4*)(bias + c0 + 128 * bj + 4 * n);
#pragma unroll
        for (int ai = 0; ai < 2; ++ai)
#pragma unroll
            for (int m = 0; m < 4; ++m) {
                const long row = 256L * u.pm + 128 * ai + 64 * wr + 16 * m + fr;
#pragma unroll
                for (int bj = 0; bj < 2; ++bj) {
                    float o[8];
#pragma unroll
                    for (int n = 0; n < 2; ++n)
#pragma unroll
                        for (int j = 0; j < 4; ++j) {
                            const float sg = sigmoidf_(acc[ai][bj][m][n][j] + bv[bj][n][j]);
                            o[4 * n + j] = type ? sg : (1.0f - __expf(-0.60653065971f * sg));
                        }
                    *(u32x4*)(O + (row * 2 + z) * 1024 + c0 + 128 * bj) = pack8(o);
                }
                __builtin_amdgcn_sched_barrier(0);
            }
    }
};
struct EpiResid {
    static constexpr bool PERM = true; static constexpr int BMAP = 0;
    const float* gate; bf16_t* T; float hs;
    DEV void operator()(const f32x4 (&acc)[2][2][4][2], const Unit& u, int wr, int wc, int fr, int fq) const {
#pragma unroll
        for (int ai = 0; ai < 2; ++ai)
#pragma unroll
            for (int m = 0; m < 4; ++m) {
                const long row = 256L * u.pm + 128 * ai + 64 * wr + 16 * m + fr;
                const float* gp = gate + (row >> 12) * 6144;
#pragma unroll
                for (int bj = 0; bj < 2; ++bj) {
                    const int col = 256 * u.pn + 128 * bj + 32 * wc + 8 * fq;
                    const f32x4 g0 = *(const f32x4*)(gp + col), g1 = *(const f32x4*)(gp + col + 4);
                    float o[8];
#pragma unroll
                    for (int j = 0; j < 4; ++j) { o[j] = (1.0f + g0[j]) * (acc[ai][bj][m][0][j] * hs); o[4 + j] = (1.0f + g1[j]) * (acc[ai][bj][m][1][j] * hs); }
                    *(u32x4*)(T + row * DM + col) = pack8(o);
                }
            }
    }
};
struct EpiMoe1 {
    static constexpr bool PERM = true; static constexpr int BMAP = 0;
    bf16_t* H;
    DEV void operator()(const f32x4 (&acc)[2][2][4][2], const Unit& u, int wr, int wc, int fr, int fq) const {
#pragma unroll
        for (int ai = 0; ai < 2; ++ai)
#pragma unroll
            for (int m = 0; m < 4; ++m) {
                const long row = 256L * u.pm + 128 * ai + 64 * wr + 16 * m + fr;
                float o[8];
#pragma unroll
                for (int n = 0; n < 2; ++n)
#pragma unroll
                    for (int j = 0; j < 4; ++j) o[4 * n + j] = siluf_(acc[ai][0][m][n][j]) * acc[ai][1][m][n][j];
                *(u32x4*)(H + row * DEXP + 128 * u.pn + 32 * wc + 8 * fq) = pack8(o);
                __builtin_amdgcn_sched_barrier(0);
            }
    }
};
struct EpiMoe2 {
    static constexpr bool PERM = true; static constexpr int BMAP = 1;
    unsigned char* slot; LAS const unsigned char* ltab; bool skip;
    DEV void operator()(const f32x4 (&acc)[2][2][4][2], const Unit& u, int wr, int wc, int fr, int fq) const {
#pragma unroll
        for (int ai = 0; ai < 2; ++ai)
#pragma unroll
            for (int m = 0; m < 4; ++m) {
                const int rl = 128 * ai + 64 * wr + 16 * m + fr;
                const u32x2 rec = *(LAS const u32x2*)(ltab + (u.tsel * 256 + rl) * 8);
                const float g = __uint_as_float(rec.y) * 64.0f;
                u32x4 w;
#pragma unroll
                for (int bj = 0; bj < 2; ++bj)
#pragma unroll
                    for (int n = 0; n < 2; ++n) {
                        float o[4];
#pragma unroll
                        for (int j = 0; j < 4; ++j) o[j] = __builtin_amdgcn_fmed3f(acc[ai][bj][m][n][j] * g, -440.f, 440.f);
                        w[2 * bj + n] = pack4_fp8(o[0], o[1], o[2], o[3]);
                    }
                long dst = rec.x; if (skip) dst = (256L * u.pm + rl) % 147456;
                *(u32x4*)(slot + dst * DM + 256 * u.pn + 64 * wc + 16 * fq) = w;
            }
    }
};

constexpr int HTB = 128 * 64 * 2;
DEV int lds_byte(int r, int c) { const int st = (r >> 4) * 2 + (c >> 5), rr = r & 15, cc = c & 31, ob = rr * 64 + cc * 2; return st * 1024 + (ob ^ (((ob >> 9) & 1) << 5)); }
DEV void stage_rc(int b, int& R, int& C) { const int st = b / 1024, sb = b % 1024, swz = sb ^ (((sb >> 9) & 1) << 5); R = (st >> 1) * 16 + swz / 64; C = (st & 1) * 32 + (swz % 64) / 2; }

template <int TAB, int ESZ, class Epi, class Sched>
DEV void gemm_phase_fast(LAS unsigned char* lds, const int wv, const long lda, const long ldb, const int K, const Sched& S, const Epi& E) {
    const int tid = opaque_tid(wv);
    const int wid = __builtin_amdgcn_readfirstlane(tid >> 6), lane = tid & 63, wr = wid >> 2, wc = wid & 3, fr = lane & 15, fq = lane >> 4;
    const int nt = K * ESZ / 128;
    constexpr bool GATHER = (TAB == 1);
    LAS unsigned char* tabl = lds + 131072;
    int sR[2], sC[2];
    unsigned voffB[2], voffB1[2], vA0[2], vA1[2], nA0[2], nA1[2];
#pragma unroll
    for (int i = 0; i < 2; ++i) { stage_rc(tid * 16 + i * 8192, sR[i], sC[i]); const int pr = Epi::PERM ? perm32(sR[i] & 31) : (sR[i] & 31);
        const int R0 = Epi::BMAP == 1 ? (64 * (sR[i] >> 5) + 16 * (pr >> 3) + (pr & 7)) : (32 * (sR[i] >> 5) + pr), R1 = Epi::BMAP == 1 ? (R0 + 8) : (R0 + 128);
        voffB[i] = (unsigned)((long)R0 * ldb * ESZ + 2 * sC[i]); voffB1[i] = (unsigned)((long)R1 * ldb * ESZ + 2 * sC[i]); }
    const size_t kstep = 128;
    const unsigned ldsw = (unsigned)wid * 1024u;
    const int aoff = ESZ == 2 ? lds_byte(wr * 64 + fr, fq * 8) : lds_byte(wr * 64 + fr, fq * 16), boff = ESZ == 2 ? lds_byte(wc * 32 + fr, fq * 8) : lds_byte(wc * 32 + fr, fq * 16);
#define PG8_SA(b, h) (((b) * 2 + (h)) * HTB)
#define PG8_SB(b, h) ((4 + (b) * 2 + (h)) * HTB)
#define PG8_STAGE(bufoff, gbase, voff) do { _Pragma("unroll") for (int _i = 0; _i < 2; ++_i) \
        __builtin_amdgcn_global_load_lds((const unsigned*)((const char*)(gbase) + (voff)[_i]), (LAS unsigned*)(lds + (bufoff) + ldsw + _i * 8192), 16, 0, 0); } while (0)
#define PG8_LDA(dst, b, h) do { _Pragma("unroll") for (int m = 0; m < 4; ++m) { \
        if constexpr (ESZ == 2) { _Pragma("unroll") for (int k = 0; k < 2; ++k) dst[m][k] = *(const LAS bf16x8*)(lds + PG8_SA(b, h) + aoff + m * 2048 + k * 1024); } \
        else { const i32x4 _lo = *(const LAS i32x4*)(lds + PG8_SA(b, h) + aoff + m * 2048), _hi = *(const LAS i32x4*)(lds + PG8_SA(b, h) + aoff + m * 2048 + 16); \
               dst##8[m] = __builtin_shufflevector(_lo, _hi, 0, 1, 2, 3, 4, 5, 6, 7); } } } while (0)
#define PG8_LDB(dst, b, h) do { _Pragma("unroll") for (int n = 0; n < 2; ++n) { \
        if constexpr (ESZ == 2) { _Pragma("unroll") for (int k = 0; k < 2; ++k) dst[n][k] = *(const LAS bf16x8*)(lds + PG8_SB(b, h) + boff + n * 2048 + k * 1024); } \
        else { const i32x4 _lo = *(const LAS i32x4*)(lds + PG8_SB(b, h) + boff + n * 2048), _hi = *(const LAS i32x4*)(lds + PG8_SB(b, h) + boff + n * 2048 + 16); \
               dst##8[n] = __builtin_shufflevector(_lo, _hi, 0, 1, 2, 3, 4, 5, 6, 7); } } } while (0)
#define PG8_MMA(ai, bj, At, Bt) do { __builtin_amdgcn_s_setprio(1); _Pragma("unroll") for (int m = 0; m < 4; ++m) _Pragma("unroll") for (int n = 0; n < 2; ++n) { \
        if constexpr (ESZ == 2) { _Pragma("unroll") for (int k = 0; k < 2; ++k) acc[ai][bj][m][n] = __builtin_amdgcn_mfma_f32_16x16x32_bf16(Bt[n][k], At[m][k], acc[ai][bj][m][n], 0, 0, 0); } \
        else asm volatile("v_mfma_scale_f32_16x16x128_f8f6f4 %0, %1, %2, %0, %3, %4 op_sel_hi:[0,0,0]" : "+v"(acc[ai][bj][m][n]) : "v"(Bt##8[n]), "v"(At##8[m]), "v"(mxscale_w), "v"(mxscale)); } \
        __builtin_amdgcn_s_setprio(0); } while (0)
#define PG8_WAIT_V(n) asm volatile("s_waitcnt vmcnt(" #n ")" ::: "memory")
#define PG8_WAIT_L(n) asm volatile("s_waitcnt lgkmcnt(" #n ")" ::: "memory")
#define PG8_BAR __builtin_amdgcn_s_barrier()
#define PG8_SCHED __builtin_amdgcn_sched_barrier(0)
#define PG8_AOFFS(u, o0, o1) do { _Pragma("unroll") for (int _i = 0; _i < 2; ++_i) { \
        const long _r0 = GATHER ? (long)*(LAS const int*)(tabl + ((u).tsel * 256 + sR[_i]) * 8) : (long)sR[_i], _r1 = GATHER ? (long)*(LAS const int*)(tabl + ((u).tsel * 256 + 128 + sR[_i]) * 8) : (long)(128 + sR[_i]); \
        o0[_i] = (unsigned)(_r0 * lda * ESZ + 2 * sC[_i]); o1[_i] = (unsigned)(_r1 * lda * ESZ + 2 * sC[_i]); } } while (0)
    Unit cur, nxt; int ui = 0;
    if (!S.next(0, cur)) return;
    f32x4 acc[2][2][4][2];
#pragma unroll
    for (int a = 0; a < 2; ++a)
#pragma unroll
        for (int b = 0; b < 2; ++b)
#pragma unroll
            for (int m = 0; m < 4; ++m)
#pragma unroll
                for (int n = 0; n < 2; ++n) acc[a][b][m][n] = (f32x4){0.f, 0.f, 0.f, 0.f};
    typedef int i32x8 __attribute__((ext_vector_type(8))); typedef int i32x4 __attribute__((ext_vector_type(4)));
    bf16x8 At[4][2], B0[2][2], B1[2][2];
    const int mxscale = 0x7F7F7F7F, mxscale_w = 0x7A7A7A7A;
    i32x8 At8[4], B08[2], B18[2];
    const char* cA = (const char*)cur.A; const char* cB = (const char*)cur.Bt;
    cur.tsel = 0;
    if (TAB) {
        if (tid < 256) { if (TAB == 1) *(LAS int*)(tabl + tid * 8) = ((const int*)cur.tab)[tid]; else *(LAS u32x2*)(tabl + tid * 8) = ((const u32x2*)cur.tab)[tid]; }
        __syncthreads();
    }
    PG8_AOFFS(cur, vA0, vA1);
    PG8_STAGE(PG8_SB(0, 0), cB, voffB); PG8_STAGE(PG8_SA(0, 0), cA, vA0); PG8_STAGE(PG8_SB(0, 1), cB, voffB1); PG8_STAGE(PG8_SA(0, 1), cA, vA1);
    if (wr == 1) PG8_BAR;
    PG8_WAIT_V(4); PG8_BAR;
    PG8_STAGE(PG8_SB(1, 0), cB + kstep, voffB); PG8_STAGE(PG8_SA(1, 0), cA + kstep, vA0); PG8_STAGE(PG8_SB(1, 1), cB + kstep, voffB1);
    PG8_WAIT_V(6); PG8_BAR;
    for (;;) {
        const bool has_next = S.next(ui + 1, nxt);
        const char* nA = has_next ? (const char*)nxt.A : cA; const char* nB = has_next ? (const char*)nxt.Bt : cB;
        nxt.tsel = (ui + 1) & 1;
        if (GATHER) {
#pragma unroll
            for (int i = 0; i < 2; ++i) { nA0[i] = vA0[i]; nA1[i] = vA1[i]; } }
#pragma unroll 1
        for (int t = 0; t < nt; t += 2) {
            const bool last = (t == nt - 2);
            const bool tabtrip = TAB && has_next && (t == nt - 4) && (tid < 256);
            u32x2 tq;
            if (tabtrip) { const unsigned long long tp = (unsigned long long)nxt.tab;
                           const unsigned long long tps = ((unsigned long long)(unsigned)__builtin_amdgcn_readfirstlane((int)(tp >> 32)) << 32) | (unsigned)__builtin_amdgcn_readfirstlane((int)tp);
                           if (TAB == 1) asm volatile("s_nop 4\n\tglobal_load_dword %0, %1, %2" : "=v"(tq.x) : "v"(tid * 4), "s"(tps) : "memory");
                           else asm volatile("s_nop 4\n\tglobal_load_dwordx2 %0, %1, %2" : "=v"(tq) : "v"(tid * 8), "s"(tps) : "memory"); }
            const char* a1 = cA + (size_t)(t + 1) * kstep;
            const char* a2 = last ? nA : cA + (size_t)(t + 2) * kstep; const char* b2 = last ? nB : cB + (size_t)(t + 2) * kstep;
            const char* a3 = a2 + kstep; const char* b3 = b2 + kstep;
            PG8_LDB(B0, 0, 0); PG8_SCHED; PG8_LDA(At, 0, 0); PG8_STAGE(PG8_SA(1, 1), a1, vA1);
            PG8_WAIT_L(8); PG8_BAR; PG8_WAIT_L(0); PG8_MMA(0, 0, At, B0); PG8_BAR; PG8_SCHED;
            PG8_LDB(B1, 0, 1); PG8_STAGE(PG8_SB(0, 0), b2, voffB);
            PG8_BAR; PG8_WAIT_L(0); PG8_MMA(0, 1, At, B1); PG8_BAR;
            if (GATHER && last && has_next) PG8_AOFFS(nxt, nA0, nA1);
            unsigned x0[2], x1[2];
#pragma unroll
            for (int i = 0; i < 2; ++i) { x0[i] = (GATHER && last) ? nA0[i] : vA0[i]; x1[i] = (GATHER && last) ? nA1[i] : vA1[i]; }
            PG8_LDA(At, 0, 1); PG8_STAGE(PG8_SA(0, 0), a2, x0);
            PG8_BAR; PG8_WAIT_L(0); PG8_MMA(1, 0, At, B0); PG8_BAR; PG8_SCHED;
            PG8_STAGE(PG8_SB(0, 1), b2, voffB1);
            PG8_WAIT_V(6); PG8_BAR; PG8_MMA(1, 1, At, B1); PG8_BAR;
            PG8_LDB(B0, 1, 0); PG8_SCHED; PG8_LDA(At, 1, 0); PG8_STAGE(PG8_SA(0, 1), a2, x1);
            PG8_WAIT_L(8); PG8_BAR; PG8_WAIT_L(0); PG8_MMA(0, 0, At, B0); PG8_BAR; PG8_SCHED;
            PG8_LDB(B1, 1, 1); PG8_STAGE(PG8_SB(1, 0), b3, voffB);
            PG8_BAR; PG8_WAIT_L(0); PG8_MMA(0, 1, At, B1); PG8_BAR;
            PG8_LDA(At, 1, 1); PG8_STAGE(PG8_SA(1, 0), a3, x0);
            PG8_BAR; PG8_WAIT_L(0); PG8_MMA(1, 0, At, B0); PG8_BAR; PG8_SCHED;
            PG8_STAGE(PG8_SB(1, 1), b3, voffB1);
            PG8_WAIT_V(6); PG8_BAR; PG8_MMA(1, 1, At, B1); PG8_BAR;
            if (tabtrip) { if (TAB == 1) *(LAS unsigned*)(tabl + (nxt.tsel * 256 + tid) * 8) = tq.x; else *(LAS u32x2*)(tabl + (nxt.tsel * 256 + tid) * 8) = tq; }
        }
        { int fr_ = fr, fq_ = fq; asm volatile("" : "+v"(fr_), "+v"(fq_));
          E(acc, cur, wr, wc, fr_, fq_); }
        if (!has_next) break;
#pragma unroll
        for (int a = 0; a < 2; ++a)
#pragma unroll
            for (int b = 0; b < 2; ++b)
#pragma unroll
                for (int m = 0; m < 4; ++m)
#pragma unroll
                    for (int n = 0; n < 2; ++n) acc[a][b][m][n] = (f32x4){0.f, 0.f, 0.f, 0.f};
        cur = nxt; cA = nA; cB = nB; ++ui;
        if (GATHER) {
#pragma unroll
            for (int i = 0; i < 2; ++i) { vA0[i] = nA0[i]; vA1[i] = nA1[i]; } }
    }
    PG8_WAIT_V(0);
    if (wr == 0) PG8_BAR;
    PG8_BAR;
#undef PG8_SA
#undef PG8_SB
#undef PG8_STAGE
#undef PG8_LDA
#undef PG8_LDB
#undef PG8_MMA
#undef PG8_WAIT_V
#undef PG8_WAIT_L
#undef PG8_BAR
#undef PG8_SCHED
#undef PG8_AOFFS
}

DEV bool unit_order(int i, int nM, int nN, int& pm, int& pn) {
    const int nwg = nM * nN; const long L = (long)i * gridDim.x + blockIdx.x; if (L >= nwg) return false;
    int wgid = (int)L; { const int q = nwg / 8, r = nwg % 8, xcd = wgid % 8, off = wgid / 8; wgid = (xcd < r ? xcd * (q + 1) : r * (q + 1) + (xcd - r) * q) + off; }
    const int nig = 8 * nN, gid = wgid / nig, fm = gid * 8, gsz = (nM - fm) < 8 ? (nM - fm) : 8;
    pm = fm + ((wgid % nig) % gsz); pn = (wgid % nig) / gsz; return true;
}
struct SchedPlain { const bf16_t* A; long lda; const bf16_t* Bt; long ldb; int nM, nN; long ldo;
    DEV bool next(int i, Unit& u) const { int pm, pn; if (!unit_order(i, nM, nN, pm, pn)) return false;
        u.pm = pm; u.pn = pn; u.e = 0; u.arow = nullptr; u.tab = nullptr; u.A = A + (long)pm * 256 * lda; u.Bt = Bt + (long)pn * 256 * ldb; u.ooff = (long)pm * 256 * ldo + (long)pn * 256; return true; } };
struct SchedF1 { const bf16_t* dft1; const bf16_t* zf;
    DEV bool next(int i, Unit& u) const { const long L = (long)i * gridDim.x + blockIdx.x; if (L >= 256) return false;
        const int b = (int)L >> 6, g = ((int)L >> 4) & 3, which = ((int)L >> 3) & 1, tt = (int)L & 7;
        u.pm = 0; u.pn = 0; u.e = 0; u.arow = nullptr; u.tab = nullptr; u.A = dft1 + which * 65536; u.Bt = zf + ((long)((b * 2 + which) * 2048 + tt * 256) * 1024 + g * 256);
        u.ooff = ((long)(b * 1024 + g * 256) * 4096 + which * 2048 + tt * 256); return true; } };
struct SchedF2 { const bf16_t* dft2; const bf16_t* wtf;
    DEV bool next(int i, Unit& u) const { const long L = (long)i * gridDim.x + blockIdx.x; if (L >= 256) return false;
        const int b = (int)L >> 6, which = ((int)L >> 5) & 1, pm = ((int)L >> 2) & 7, pn = (int)L & 3;
        u.pm = pm; u.pn = pn; u.e = 0; u.arow = nullptr; u.tab = nullptr; u.A = dft2 + ((long)which * 2048 + pm * 256) * 2048; u.Bt = wtf + (long)(b * 1024 + pn * 256) * 4096 + which * 2048;
        u.ooff = ((long)(b * 2 + which) * 2048 + pm * 256) * 1024 + pn * 256; return true; } };
struct SchedMoe1 { const unsigned char* U; const int* row_src; LAS const int* tile_e; const unsigned char* w1l; int ntiles;
    DEV bool next(int i, Unit& u) const { int rt, pn; { const int nwg = ntiles * 4; const long L = (long)i * gridDim.x + blockIdx.x; if (L >= nwg) return false;
        int wgid = (int)L; const int q = nwg / 8, r = nwg % 8, xcd = wgid % 8, off = wgid / 8; wgid = (xcd < r ? xcd * (q + 1) : r * (q + 1) + (xcd - r) * q) + off;
        rt = wgid >> 2; pn = wgid & 3; }
        const int e = tile_e[rt];
        u.pm = rt; u.pn = pn; u.e = e; u.arow = row_src + (long)rt * 256; u.tab = u.arow; u.A = (const bf16_t*)U; u.Bt = (const bf16_t*)(w1l + ((long)e * 1024 + pn * 256) * DM); u.ooff = 0; return true; } };
struct SchedMoe2 { const bf16_t* H; const u32x2* row_rec; LAS const int* tile_e; const bf16_t* w2l; int ntiles;
    DEV bool next(int i, Unit& u) const { int rt, pn; if (!unit_order(i, ntiles, 8, rt, pn)) return false; const int e = tile_e[rt];
        u.pm = rt; u.pn = pn; u.e = e; u.arow = nullptr; u.tab = row_rec + (long)rt * 256; u.A = H + (long)rt * 256 * DEXP; u.Bt = w2l + ((long)e * DM + pn * 256) * DEXP; u.ooff = 0; return true; } };

struct TJob { const float* src; int ld_src, Nn, k0, n0; bf16_t* dst; int ld_dst, kind; float scale; };
constexpr int TJ_WIN = 32 * 18, TJ_SQ = 32 * 8, TJ_QKV = 32 * 24, TJ_EXP = 65 * 3 * 64;
constexpr int TJ_SPLIT = CONV_IN_SCAN ? (TJ_WIN) : (TJ_WIN + 2 * TJ_SQ + TJ_QKV + 2 * TJ_EXP);
DEV void expert_job(const Params& p, int L, int layer, TJob& j) {
    const int e = L / 192, rem = L % 192, kind = rem / 64, tl = rem % 64, mat = layer * 65 + e;
    if (kind < 2) {
        j.src = (e < 64) ? ((kind ? p.exp_up : p.exp_gate) + ((long)(layer * 64 + e) * DM * DEXP)) : ((kind ? p.sh_up : p.sh_gate) + (long)layer * DM * DEXP);
        j.ld_src = DEXP; j.Nn = DEXP; j.k0 = (tl >> 1) * 64; j.n0 = (tl & 1) * 256; j.dst = (bf16_t*)(p.w1 + (long)mat * 1024 * DM); j.ld_dst = DM; j.kind = 1 + kind; j.scale = 32.0f;
    } else {
        j.src = (e < 64) ? (p.exp_down + ((long)(layer * 64 + e) * DEXP * DM)) : (p.sh_down + (long)layer * DEXP * DM);
        j.ld_src = DM; j.Nn = DM; j.k0 = (tl >> 3) * 64; j.n0 = (tl & 7) * 256; j.dst = p.w2 + (long)mat * DM * DEXP; j.ld_dst = DEXP;
    }
}
DEV bool prologue_job(const Params& p, int L, TJob& j) {
    j.scale = 1.0f; j.kind = 0;
    if (L < TJ_WIN) { j.src = p.ab_w_in; j.ld_src = IN_AB; j.Nn = IN_AB; j.k0 = (L / 18) * 64; j.n0 = (L % 18) * 256; j.dst = p.wt_in; j.ld_dst = DM; return true; }
    L -= TJ_WIN;
    if (L < TJ_SQ) { j.src = p.ab_w_out; j.ld_src = DM; j.Nn = DM; j.k0 = (L / 8) * 64; j.n0 = (L % 8) * 256; j.dst = p.wt_out0; j.ld_dst = DM; return true; }
    L -= TJ_SQ;
    if (L < TJ_EXP) { expert_job(p, L, 0, j); return true; }
    L -= TJ_EXP;
    if (L < TJ_QKV) { j.src = p.dsa_w_qkv; j.ld_src = 3 * DM; j.Nn = 3 * DM; j.k0 = (L / 24) * 64; j.n0 = (L % 24) * 256; j.dst = p.wt_qkv; j.ld_dst = DM; j.kind = 3; j.scale = 32.0f; return true; }
    L -= TJ_QKV;
    if (L < TJ_SQ) { j.src = p.dsa_w_out; j.ld_src = DM; j.Nn = DM; j.k0 = (L / 8) * 64; j.n0 = (L % 8) * 256; j.dst = p.wt_o1; j.ld_dst = DM; return true; }
    L -= TJ_SQ;
    if (L < TJ_EXP) { expert_job(p, L, 1, j); return true; }
    return false;
}
DEV void tjob_load(const TJob& j, int tid, f32x4 (&v)[8]) {
    const int kq = tid >> 6, n = j.n0 + 4 * (tid & 63);
#pragma unroll
    for (int i = 0; i < 8; ++i) v[i] = (n < j.Nn) ? *(const f32x4*)(j.src + (long)(j.k0 + kq * 8 + i) * j.ld_src + n) : (f32x4){0.f, 0.f, 0.f, 0.f};
}
DEV void tjob_store(const TJob& j, int tid, const f32x4 (&v)[8], LAS unsigned char* lds) {
    const int kq = tid >> 6, nl = tid & 63;
#pragma unroll
    for (int c = 0; c < 4; ++c) {
        u32x4 w; w.x = cvt_pk_bf16(v[0][c] * j.scale, v[1][c] * j.scale); w.y = cvt_pk_bf16(v[2][c] * j.scale, v[3][c] * j.scale);
        w.z = cvt_pk_bf16(v[4][c] * j.scale, v[5][c] * j.scale); w.w = cvt_pk_bf16(v[6][c] * j.scale, v[7][c] * j.scale);
        *(LAS u32x4*)(lds + (4 * nl + c) * 128 + ((kq ^ (nl & 7)) * 16)) = w;
    }
    __syncthreads();
#pragma unroll
    for (int ps = 0; ps < 4; ++ps) {
        const int nr = ps * 64 + (tid >> 3), slot = tid & 7, n = j.n0 + nr;
        const u32x4 w = *(const LAS u32x4*)(lds + nr * 128 + ((slot ^ ((nr >> 2) & 7)) * 16));
        const long drow = j.kind ? (256 * (n >> 7) + 128 * (j.kind - 1) + (n & 127)) : n;
        if (n < j.Nn) *(u32x4*)(j.dst + drow * j.ld_dst + j.k0 + slot * 8) = w;
    }
    __syncthreads();
}

DEV void phase_prologue(const Params& p, const int WV, LAS unsigned char* lds) {
    const int TIDX = opaque_tid(WV);
    const int G = gridDim.x, tid = TIDX;
    const long gtid = (long)blockIdx.x * NTHREADS + tid, gsz = (long)G * NTHREADS;
    {
        TJob cur, nxt; f32x4 va[8], vb[8];
        int L = blockIdx.x; bool have = L < TJ_SPLIT && prologue_job(p, L, cur);
        if (have) tjob_load(cur, tid, va);
        while (have) {
            const bool hn = L + G < TJ_SPLIT && prologue_job(p, L + G, nxt);
            if (hn) tjob_load(nxt, tid, vb);
            tjob_store(cur, tid, va, lds);
            if (!hn) break;
            L += 2 * G;
            const bool hc = L < TJ_SPLIT && prologue_job(p, L, cur);
            if (hc) tjob_load(cur, tid, va);
            tjob_store(nxt, tid, vb, lds);
            have = hc;
        }
    }
    for (long i = gtid; i < (long)(INP - IN_AB) * DM / 8; i += gsz) *(u32x4*)(p.wt_in + (long)IN_AB * DM + i * 8) = (u32x4){0u, 0u, 0u, 0u};
    for (long i = gtid; i < 256L * DM / 8; i += gsz) *(u32x4*)(p.U + (long)NTOK * DM + i * 8) = (u32x4){0u, 0u, 0u, 0u};
    for (long i = gtid; i < 256L * DM / 16; i += gsz) *(u32x4*)(p.U8 + (long)NTOK * DM + i * 16) = (u32x4){0u, 0u, 0u, 0u};
    for (long i = gtid; i < 128; i += gsz) p.gcnt[i] = 0;
    if (gtid == 0) p.meta[8] = 0;
    for (long i = gtid; i < 4096L * 256; i += gsz) {
        const int n = (int)(i >> 8), k = (int)(i & 255), type = n >> 11, z = (n >> 10) & 1, c = n & 1023;
        const int kb = 128 * type + 64 * z; float v = 0.f;
        if (k >= kb && k < kb + 64) v = (type ? p.ab_a_up : p.ab_w_up)[((long)z * 64 + (k - kb)) * 1024 + c];
        p.wl_wa[i] = f2bf(v);
    }
    for (long i = gtid; i < 1024L * 256; i += gsz) {
        const int n = (int)(i >> 8), k = (int)(i & 255);
        p.wl_g[i] = f2bf(k < 160 ? p.ab_g_up[(long)k * 1024 + n] : 0.f);
    }
    for (long i = gtid; i < 2L * 256 * 256; i += gsz) {
        const int which = (int)(i >> 16), c = (int)((i >> 8) & 255), f = (int)(i & 255), m = (c * f) & 255;
        const float a = (float)m * (1.0f / 128.0f);
        p.dft1[i] = f2bf((which ? sinpif(a) : cospif(a)) * 0.0625f);
    }
    for (long i = gtid; i < 2L * 2048 * 2048 / 8; i += gsz) {
        const int which = (int)(i >> 19), tp = (int)(i >> 8) & 2047, k0 = (int)(i & 255) * 8;
        float o[8];
#pragma unroll
        for (int j = 0; j < 8; ++j) { const int m = (tp * (k0 + j)) & 4095; const float a = (float)m * (1.0f / 2048.0f); o[j] = (which ? sinpif(a) : cospif(a)) * 0.015625f; }
        *(u32x4*)(p.dft2 + i * 8) = pack8(o);
    }
    {
        LAS float* sc = (LAS float*)lds;
        LAS float* red = (LAS float*)(lds + 32768);
        for (int i = tid; i < 4 * DM; i += NTHREADS) sc[i] = siluf_(p.c[i]);
        __syncthreads();
        for (int L = blockIdx.x; L < 4 * 48; L += G) {
            const int m = L / 48, cb = L % 48;
            const float* w = ((m & 1) ? p.ada_ffn_w : p.ada_mix_w) + (long)(m >> 1) * DM * 6144;
            const float* bias = ((m & 1) ? p.ada_ffn_b : p.ada_mix_b) + (long)(m >> 1) * 6144;
            const int kg = tid >> 5, c4 = (tid & 31) * 4;
            f32x4 a0 = {0, 0, 0, 0}, a1 = a0, a2 = a0, a3 = a0;
            for (int k = kg * 128; k < kg * 128 + 128; ++k) {
                const f32x4 wv = *(const f32x4*)(w + (long)k * 6144 + cb * 128 + c4);
                a0 += sc[k] * wv; a1 += sc[DM + k] * wv; a2 += sc[2 * DM + k] * wv; a3 += sc[3 * DM + k] * wv;
            }
            *(LAS f32x4*)(red + (kg * 4 + 0) * 128 + c4) = a0; *(LAS f32x4*)(red + (kg * 4 + 1) * 128 + c4) = a1;
            *(LAS f32x4*)(red + (kg * 4 + 2) * 128 + c4) = a2; *(LAS f32x4*)(red + (kg * 4 + 3) * 128 + c4) = a3;
            __syncthreads();
            { const int b = tid >> 7, col = tid & 127; float s = bias[cb * 128 + col];
#pragma unroll
              for (int g = 0; g < 16; ++g) s += red[(g * 4 + b) * 128 + col];
              p.mod[((long)m * 4 + b) * 6144 + cb * 128 + col] = s; }
            __syncthreads();
        }
    }
}

DEV void phase_modulate(const Params& p, const int WV, const float* xin, int m) {
    const int TIDX = opaque_tid(WV);
    const long gtid = (long)blockIdx.x * NTHREADS + TIDX, gsz = (long)gridDim.x * NTHREADS;
    for (long i = gtid; i < (long)NTOK * DM / 8; i += gsz) {
        const long row = i >> 8; const int col = (int)(i & 255) * 8;
        const float* md = p.mod + ((long)m * 4 + (row >> 12)) * 6144;
        float o[8];
#pragma unroll
        for (int h = 0; h < 2; ++h) {
            const f32x4 xv = *(const f32x4*)(xin + row * DM + col + 4 * h), sh = *(const f32x4*)(md + col + 4 * h), sc = *(const f32x4*)(md + DM + col + 4 * h);
#pragma unroll
            for (int j = 0; j < 4; ++j) o[4 * h + j] = xv[j] * (1.0f + sc[j]) + sh[j];
        }
        *(u32x4*)(p.U + row * DM + col) = pack8(o);
    }
}

template <int ESZ = 2, class Epi>
DEV void phase_gemm_plain(LAS unsigned char* lds, const int wv, const bf16_t* A, long lda, const bf16_t* Bt, long ldb, int M, int N, int K, long ldo, const Epi& E) {
#if GEMM_FAST
    { SchedPlain S{A, lda * ESZ / 2, Bt, ldb * ESZ / 2, M / 256, N / 256, ldo}; gemm_phase_fast<0, ESZ>(lds, wv, lda, ldb, K, S, E); return; }
#endif
    const int nN = N / 256, total = (M / 256) * nN;
    for (int L = blockIdx.x; L < total; L += gridDim.x) {
        Unit u; u.pm = L / nN; u.pn = L % nN; u.e = 0; u.arow = nullptr;
        u.A = A + (long)u.pm * 256 * lda; u.Bt = Bt + (long)u.pn * 256 * ldb; u.ooff = (long)u.pm * 256 * ldo + (long)u.pn * 256;
        gemm_tile_simple(u, lda, ldb, K, E);
    }
}
DEV void phase_fourier1(const Params& p, const int WV, LAS unsigned char* lds) {
    const int wv = WV;
    EpiBf16 E{p.wtf, 4096, 0, 1.0f};
    SchedF1 S{p.dft1, p.zf}; gemm_phase_fast<0, 2>(lds, wv, 256, 1024, 256, S, E);
}
DEV void phase_fourier2(const Params& p, const int WV, LAS unsigned char* lds) {
    const int wv = WV;
    EpiBf16 E{p.pq, 1024, 0, 1.0f};
    SchedF2 S{p.dft2, p.wtf}; gemm_phase_fast<0, 2>(lds, wv, 2048, 4096, 2048, S, E);
}
DEV void phase_fold(const Params& p, const int WV) {
    const int tid = opaque_tid(WV);
    for (long i = (long)blockIdx.x * NTHREADS + tid; i < 4L * 2048 * 128; i += (long)gridDim.x * NTHREADS) {
        const int b = (int)(i >> 18), t = (int)(i >> 7) & 2047, c = (int)(i & 127) * 8;
        float x[8], y[8], e[8], o[8];
        unpack8(*(const u32x4*)(p.proj + ((long)b * 4096 + t) * INP + c), x);
        if (t > 0) unpack8(*(const u32x4*)(p.proj + ((long)b * 4096 + 4096 - t) * INP + c), y);
#pragma unroll
        for (int j = 0; j < 8; ++j) { const float yy = t > 0 ? y[j] : 0.f; e[j] = x[j] + yy; o[j] = t > 0 ? x[j] - yy : 0.f; }
        *(u32x4*)(p.zf + ((long)(b * 2 + 0) * 2048 + t) * 1024 + c) = pack8(e);
        *(u32x4*)(p.zf + ((long)(b * 2 + 1) * 2048 + t) * 1024 + c) = pack8(o);
    }
}
DEV void phase_wn(const Params& p, const int WV) {
    const int tid = opaque_tid(WV), lane = tid & 63;
    for (int it = blockIdx.x * 8 + (tid >> 6); it < 4096; it += gridDim.x * 8) {
        const int b = it >> 10, c = it & 1023, g = c >> 8, cl = c & 255;
        const u32x2 zw = *(const u32x2*)(p.proj + ((long)b * 4096 + 2048) * INP + g * 256 + 4 * lane), dw = *(const u32x2*)(p.dft1 + cl * 256 + 4 * lane);
        float sacc = bflo(zw.x) * bflo(dw.x) + bfhi(zw.x) * bfhi(dw.x) + bflo(zw.y) * bflo(dw.y) + bfhi(zw.y) * bfhi(dw.y);
        sacc = wave_sum(sacc);
        if (lane == 0) p.wn[it] = sacc;
    }
}
DEV void phase_nyquist(const Params& p, const int WV) {
    const int tid = opaque_tid(WV), lane = tid & 63;
    for (int it = blockIdx.x * 8 + (tid >> 6); it < 4096; it += gridDim.x * 8) {
        const int b = it >> 10, c = it & 1023;
        const bf16_t* row = p.wtf + (long)(b * 1024 + c) * 4096;
        float sacc = 0.f;
#pragma unroll
        for (int q = 0; q < 4; ++q) { float f[8]; unpack8(*(const u32x4*)(row + q * 512 + 8 * lane), f);
            sacc += (f[0] - f[1]) + (f[2] - f[3]) + (f[4] - f[5]) + (f[6] - f[7]); }
        sacc = wave_sum(sacc);
        if (lane == 0) p.ycat[((long)b * 4096 + 2048) * DM + c] = f2bf((sacc + p.wn[it]) * 0.015625f);
    }
}
DEV void phase_unfold(const Params& p, const int WV) {
    const int tid = opaque_tid(WV);
    for (long i = (long)blockIdx.x * NTHREADS + tid; i < 4L * 2048 * 128; i += (long)gridDim.x * NTHREADS) {
        const int b = (int)(i >> 18), t = (int)(i >> 7) & 2047, c = (int)(i & 127) * 8;
        float P[8], Q[8], lo[8], hi[8];
        unpack8(*(const u32x4*)(p.pq + ((long)(b * 2 + 0) * 2048 + t) * 1024 + c), P); unpack8(*(const u32x4*)(p.pq + ((long)(b * 2 + 1) * 2048 + t) * 1024 + c), Q);
        const f32x4 w0 = *(const f32x4*)(p.wn + b * 1024 + c), w1 = *(const f32x4*)(p.wn + b * 1024 + c + 4);
        const float sg = (t & 1) ? -0.015625f : 0.015625f;
#pragma unroll
        for (int j = 0; j < 8; ++j) { const float pw = P[j] + sg * (j < 4 ? w0[j & 3] : w1[j & 3]); lo[j] = pw - Q[j]; hi[j] = pw + Q[j]; }
        *(u32x4*)(p.ycat + ((long)b * 4096 + t) * DM + c) = pack8(lo);
        if (t > 0) *(u32x4*)(p.ycat + ((long)b * 4096 + 4096 - t) * DM + c) = pack8(hi);
    }
}
DEV void phase_moe1(const Params& p, const int WV, int layer, LAS unsigned char* lds) {
    const int wv = WV;
    EpiMoe1 E{p.H};
    const int ntiles = p.meta[0], total = ntiles * 4;
#if GEMM_FAST
    { LAS int* te = (LAS int*)(lds + 131072 + 4096);
      for (int i = opaque_tid(wv); i < ntiles; i += NTHREADS) te[i] = p.tile_e[i];
      __syncthreads();
      SchedMoe1 S{p.U8, p.row_src, te, p.w1 + (long)layer * 65 * 1024 * DM, ntiles}; gemm_phase_fast<1, 1>(lds, wv, DM, DM, DM, S, E); return; }
#endif
    (void)total;
}
DEV void phase_moe2(const Params& p, const int WV, int layer, LAS unsigned char* lds, bool skip = false) {
    const int wv = WV;
    EpiMoe2 E{p.slot, (LAS const unsigned char*)(lds + 131072), skip};
    const int ntiles = p.meta[0], total = ntiles * 8;
#if GEMM_FAST
    { LAS int* te = (LAS int*)(lds + 131072 + 4096);
      for (int i = opaque_tid(wv); i < ntiles; i += NTHREADS) te[i] = p.tile_e[i];
      __syncthreads();
      for (int d = 0; d < (int)(blockIdx.x & 3) * MOE2_STAGGER; ++d) __builtin_amdgcn_s_sleep(127);
      SchedMoe2 S{p.H, p.row_rec, te, p.w2 + (long)layer * 65 * DM * DEXP, ntiles}; gemm_phase_fast<2, 2>(lds, wv, DEXP, DEXP, DEXP, S, E); return; }
#endif
    (void)total;
}

DEV float xor_sum8(float v) { v += SHFLX(v, 1); v += SHFLX(v, 2); v += SHFLX(v, 4); return v; }
DEV void phase_rwkv_prep(const Params& p, const int WV) {
    const int tid0 = opaque_tid(WV);
    const int tid = tid0 < 448 ? tid0 : tid0 - 64;
    const int rbeg = tid0 < 448 ? 0 : 32, nrows_sel = tid0 < 384 ? 64 : 32;
    const int col = 8 * tid;
    float mp[8], mn[8];
#pragma unroll
    for (int j = 0; j < 8; ++j) { mp[j] = tid < 436 ? p.ab_mu_prev[col + j] : 0.f; mn[j] = tid < 436 ? p.ab_mu_next[col + j] : 0.f; }
    float kkw[8];
#pragma unroll
    for (int j = 0; j < 8; ++j) kkw[j] = (tid >= 128 && tid < 256) ? p.ab_k_k[col - 1024 + j] : 0.f;
    const int rows_per_block = NTOK / gridDim.x;
    const int myrows = rows_per_block * nrows_sel / 64;
    const long row0 = (long)blockIdx.x * rows_per_block + (long)rows_per_block * rbeg / 64;
    if (tid >= 436) {
        for (int i = 0; i < myrows; ++i) *(u32x4*)(p.alora + (row0 + i) * 512 + 416 + 8 * (tid - 436)) = (u32x4){0u, 0u, 0u, 0u};
        return;
    }
    const bf16_t* pc = p.proj + 1024 + col;
    const long rlast = row0 + myrows;
    auto ldrow = [&](long r) { const long rc = r < rlast ? r : rlast; return *(const u32x4*)(pc + (rc < NTOK ? rc : (long)NTOK - 1) * INP); };
    u32x4 prvq = ldrow(row0 > 0 ? row0 - 1 : 0), curq = ldrow(row0), nq[8];
#pragma unroll
    for (int k = 0; k < 8; ++k) nq[k] = ldrow(row0 + 1 + k);
#pragma unroll 1
    for (int i0 = 0; i0 < myrows; i0 += 8) {
#pragma unroll
        for (int k = 0; k < 8; ++k) {
            const long row = row0 + i0 + k; const int t = (int)(row & 4095);
            const u32x4 nxtq = nq[k];
            nq[k] = ldrow(row + 9);
            float cur[8], prv[8], nxt[8], v[8];
            unpack8(curq, cur); unpack8(prvq, prv); unpack8(nxtq, nxt);
#pragma unroll
            for (int j = 0; j < 8; ++j) { const float pv = t > 0 ? prv[j] : 0.f, nv = t < 4095 ? nxt[j] : 0.f; v[j] = cur[j] + mp[j] * (pv - cur[j]) + mn[j] * (nv - cur[j]); }
            if (tid < 128) *(u32x4*)(p.R + row * 1024 + col) = pack8(v);
            else if (tid < 256) {
                *(u32x4*)(p.K + row * 1024 + col - 1024) = pack8(v);
                float kv[8], ss = 0.f;
#pragma unroll
                for (int j = 0; j < 8; ++j) { kv[j] = v[j] * kkw[j]; ss += kv[j] * kv[j]; }
                ss = xor_sum8(ss);
                const float inv = 1.0f / fmaxf(sqrtf(ss), 1e-12f);
#pragma unroll
                for (int j = 0; j < 8; ++j) kv[j] *= inv;
                *(u32x4*)(p.KK + row * 1024 + col - 1024) = pack8(kv);
            } else if (tid < 384) *(u32x4*)(p.V + row * 1024 + col - 2048) = pack8(v);
            else {
                float o[8];
#pragma unroll
                for (int j = 0; j < 8; ++j) { const float e2 = __expf((tid < 400 ? 2.0f : -1.0f) * fminf(fmaxf(v[j], -15.f), 15.f)), rc = __builtin_amdgcn_rcpf(e2 + 1.0f);
                    o[j] = tid < 400 ? (e2 - 1.0f) * rc : (tid < 416 ? v[j] : rc); }
                *(u32x4*)(p.alora + row * 512 + (col - 3072)) = pack8(o);
            }
            prvq = curq; curq = nxtq;
        }
    }
}

DEV void scan_bar() { asm volatile("s_waitcnt lgkmcnt(0)" ::: "memory"); __builtin_amdgcn_s_barrier(); asm volatile("" ::: "memory"); }
DEV void phase_scan(const Params& p, const int WV, LAS unsigned char* lds, bool nosteps = false) {
    const int tid = opaque_tid(WV);
    LAS float* vec = (LAS float*)lds;
    LAS bf16_t* vbuf = (LAS bf16_t*)(lds + 81920);
    LAS float* ybuf = (LAS float*)(lds + 86016);
    LAS unsigned char* img = lds + 94208;
    const int wid = tid >> 6, lane = tid & 63;
    const int nunits = (256 - (int)blockIdx.x + (int)gridDim.x - 1) / (int)gridDim.x;
    if (wid < 4) {
        const int jg = lane & 15, rg = lane >> 4;
        __builtin_amdgcn_s_setprio(3);
        for (int L = blockIdx.x; L < 256; L += gridDim.x) {
            f32x2 S0l = {0.f, 0.f}, S0h = {0.f, 0.f}, S1l = {0.f, 0.f}, S1h = {0.f, 0.f};
            scan_bar();
#pragma unroll 1
            for (int c = 0; c < 128; ++c) {
                const int buf = c & 1;
                const LAS float* vb = vec + buf * 32 * 320 + 4 * jg;
                const LAS bf16_t* vv = vbuf + buf * 1024 + 8 * wid + 2 * rg;
                LAS float* yb = ybuf + buf * 1024 + 8 * wid + 2 * rg;
                f32x4 b4 = *(const LAS f32x4*)(vb + 64), w4 = *(const LAS f32x4*)(vb + 128), k4 = *(const LAS f32x4*)(vb + 192), r4 = *(const LAS f32x4*)(vb + 256);
                f32x4 an4 = *(const LAS f32x4*)(vb + 320);
                unsigned v2w = *(const LAS unsigned*)(vv);
                f32x4 b41 = *(const LAS f32x4*)(vb + 320 + 64), w41 = *(const LAS f32x4*)(vb + 320 + 128), k41 = *(const LAS f32x4*)(vb + 320 + 192), r41 = *(const LAS f32x4*)(vb + 320 + 256);
                f32x4 an41 = *(const LAS f32x4*)(vb + 640); unsigned v2w1 = *(const LAS unsigned*)(vv + 32);
                float sa0, sa1;
                { const f32x4 a4 = *(const LAS f32x4*)(vb);
                  const f32x2 al = {a4[0], a4[1]}, ah = {a4[2], a4[3]};
                  const f32x2 t0 = S0l * al + S0h * ah, t1 = S1l * al + S1h * ah;
                  sa0 = t0.x + t0.y; sa1 = t1.x + t1.y;
                  dpp_sum16_pair(sa0, sa1); }
#pragma unroll 4
                for (int s = 0; s < (nosteps ? 0 : 32); ++s) {
                    const f32x4 nb = *(const LAS f32x4*)(vb + (s + 2) * 320 + 64), nw = *(const LAS f32x4*)(vb + (s + 2) * 320 + 128),
                                nk = *(const LAS f32x4*)(vb + (s + 2) * 320 + 192), nr = *(const LAS f32x4*)(vb + (s + 2) * 320 + 256), na = *(const LAS f32x4*)(vb + (s + 3) * 320);
                    const unsigned nvw = *(const LAS unsigned*)(vv + (s + 2) * 32);
                    const f32x2 v2 = {bflo(v2w), bfhi(v2w)};
                    const f32x2 bl = {b4[0], b4[1]}, bh = {b4[2], b4[3]}, wl = {w4[0], w4[1]}, wh = {w4[2], w4[3]},
                                kl = {k4[0], k4[1]}, kh = {k4[2], k4[3]}, rl = {r4[0], r4[1]}, rh = {r4[2], r4[3]}, al = {an4[0], an4[1]}, ah = {an4[2], an4[3]};
                    S0l = S0l * wl + bl * sa0 + kl * v2.x; S0h = S0h * wh + bh * sa0 + kh * v2.x;
                    S1l = S1l * wl + bl * sa1 + kl * v2.y; S1h = S1h * wh + bh * sa1 + kh * v2.y;
                    const f32x2 u0 = S0l * rl + S0h * rh, u1 = S1l * rl + S1h * rh, q0 = S0l * al + S0h * ah, q1 = S1l * al + S1h * ah;
                    float y0, y1;
                    dpp_sum16_quad(y0, y1, sa0, sa1, u0, u1, q0, q1);
                    *(LAS f32x2*)(yb + s * 32) = (f32x2){y0, y1};
                    b4 = b41; w4 = w41; k4 = k41; r4 = r41; an4 = an41; v2w = v2w1; b41 = nb; w41 = nw; k41 = nk; r41 = nr; an41 = na; v2w1 = nvw;
                }
                scan_bar();
            }
        }
        __builtin_amdgcn_s_setprio(0);
        scan_bar(); scan_bar(); scan_bar();
    } else {
        int ltv = tid & 255, tc = 0;
        int ub = 0, uh = 0, uz = 0, uhalf = 0;
        float ka[8];
        u32x4 gq[2][6];
        auto gld = [&](u32x4& dst, const unsigned off, const void* ptr) {
            const unsigned long long bi = (unsigned long long)ptr;
            const unsigned lo = (unsigned)__builtin_amdgcn_readfirstlane((int)(unsigned)bi), hi = (unsigned)__builtin_amdgcn_readfirstlane((int)(unsigned)(bi >> 32));
            const unsigned long long bs = ((unsigned long long)hi << 32) | lo;
            asm volatile("s_nop 4\n\tglobal_load_dwordx4 %0, %1, %2" : "=&v"(dst) : "v"(off), "s"(bs) : "memory");
        };
        auto gload = [&](int c, const int R) {
            const int tt = c * 32 + (ltv >> 3), t = uz ? 4095 - tt : tt; const unsigned row = (unsigned)(ub * 4096 + t), col = (unsigned)(uh * 64 + 8 * (ltv & 7));
            const unsigned o1 = (row * 1024u + col) * 2u, o2 = ((row * 2u + (unsigned)uz) * 1024u + col) * 2u, o3 = (row * 1024u + (unsigned)(uh * 64 + 32 * uhalf + 8 * ((ltv & 7) & 3))) * 2u;
            gld(gq[R][0], o1, p.KK); gld(gq[R][1], o1, p.K); gld(gq[R][2], o1, p.R); gld(gq[R][3], o2, p.iclr); gld(gq[R][4], o2, p.omw); gld(gq[R][5], o3, p.V);
        };
        auto gwrite = [&](int buf, const int R) {
#pragma unroll
            for (int i = 0; i < 6; ++i) asm volatile("" : "+v"(gq[R][i]));
            float kk[8], kx[8], rx[8], ic[8], om[8];
            unpack8(gq[R][0], kk); unpack8(gq[R][1], kx); unpack8(gq[R][2], rx); unpack8(gq[R][3], ic); unpack8(gq[R][4], om);
            LAS float* d = vec + ((buf * 32 + (ltv >> 3)) * 5) * 64 + 8 * (ltv & 7);
#pragma unroll
            for (int j = 0; j < 8; ++j) {
                d[j] = -kk[j]; d[64 + j] = kk[j] * ic[j]; d[128 + j] = 1.0f - om[j]; d[192 + j] = kx[j] * (1.0f + (ic[j] - 1.0f) * ka[j]); d[256 + j] = rx[j];
            }
            if ((ltv & 7) < 4) *(LAS u32x4*)(vbuf + (buf * 32 + (ltv >> 3)) * 32 + 8 * (ltv & 7)) = gq[R][5];
        };
        auto flush = [&](int c, int buf) {
            const int tt = c * 32 + (ltv >> 3), t = uz ? 4095 - tt : tt; const long row = (long)ub * 4096 + t;
            const f32x4 yv = *(LAS f32x4*)(ybuf + (buf * 32 + (ltv >> 3)) * 32 + 4 * (ltv & 7));
            *(u32x2*)(p.Y + ((long)uz * NTOK + row) * 1024 + uh * 64 + 32 * uhalf + 4 * (ltv & 7)) = (u32x2){cvt_pk_bf16(yv[0], yv[1]), cvt_pk_bf16(yv[2], yv[3])};
        };
        f32x4 tv[2][16];
        auto tjob = [&](int jc, TJob& j) { int Lj = TJ_SPLIT + (int)blockIdx.x + (int)gridDim.x * (jc < 0 ? 0 : jc); const int last = TJ_WIN + 2 * TJ_SQ + TJ_QKV + 2 * TJ_EXP - 1;
            if (Lj > last) Lj = last; return prologue_job(p, Lj, j); };
        auto tload = [&](int jc, const int R) {
            TJob tj;
            if (tjob(jc, tj)) {
                const char* base = (const char*)(tj.src + (long)tj.k0 * tj.ld_src + tj.n0);
                const unsigned voff = (unsigned)(((ltv >> 6) * 16 * tj.ld_src + 4 * (ltv & 63)) * 4);
                const unsigned long long b0 = (unsigned long long)base, st = (unsigned long long)tj.ld_src * 4ull;
#pragma unroll
                for (int i = 0; i < 16; ++i) { const unsigned long long bi = b0 + st * (unsigned)i;
                    const unsigned lo = (unsigned)__builtin_amdgcn_readfirstlane((int)(unsigned)bi), hi = (unsigned)__builtin_amdgcn_readfirstlane((int)(unsigned)(bi >> 32));
                    const unsigned long long bs = ((unsigned long long)hi << 32) | lo;
                    asm volatile("s_nop 4\n\tglobal_load_dwordx4 %0, %1, %2" : "=&v"(tv[R][i]) : "v"(voff), "s"(bs) : "memory"); } }
        };
        auto twrite = [&](int jc, const int ib, bool steady = false) {
            TJob tj;
            if (tjob(jc, tj)) { const int kq = ltv >> 6, nl = ltv & 63;
                if (steady && jc >= 3) asm volatile("s_waitcnt vmcnt(38)" ::: "memory"); else asm volatile("s_waitcnt vmcnt(0)" ::: "memory");
#pragma unroll
                for (int i = 0; i < 16; ++i) asm volatile("" : "+v"(tv[ib][i]));
                if (tj.kind) {
#pragma unroll
                    for (int cc = 0; cc < 4; ++cc) {
                        u32x4 w;
#pragma unroll
                        for (int q = 0; q < 4; ++q) w[q] = pack4_fp8(tv[ib][4 * q][cc] * tj.scale, tv[ib][4 * q + 1][cc] * tj.scale, tv[ib][4 * q + 2][cc] * tj.scale, tv[ib][4 * q + 3][cc] * tj.scale);
                        *(LAS u32x4*)(img + ib * 32768 + (4 * nl + cc) * 64 + ((kq ^ (nl & 3)) * 16)) = w;
                    }
                } else
#pragma unroll
                for (int cc = 0; cc < 4; ++cc)
#pragma unroll
                    for (int hh = 0; hh < 2; ++hh) {
                        u32x4 w; w.x = cvt_pk_bf16(tv[ib][8 * hh][cc], tv[ib][8 * hh + 1][cc]); w.y = cvt_pk_bf16(tv[ib][8 * hh + 2][cc], tv[ib][8 * hh + 3][cc]);
                        w.z = cvt_pk_bf16(tv[ib][8 * hh + 4][cc], tv[ib][8 * hh + 5][cc]); w.w = cvt_pk_bf16(tv[ib][8 * hh + 6][cc], tv[ib][8 * hh + 7][cc]);
                        *(LAS u32x4*)(img + ib * 32768 + (4 * nl + cc) * 128 + (((2 * kq + hh) ^ (nl & 7)) * 16)) = w;
                    } }
        };
        auto tstore = [&](int jc, const int ib) {
            TJob j;
            if (tjob(jc, j) && j.kind) {
                const int sh = __builtin_ctz((unsigned)j.ld_dst);
                const unsigned voff = (unsigned)(((ltv >> 2) << sh) + (ltv & 3) * 16);
                const long urow = j.kind == 3 ? (long)j.n0 : (long)(256 * (j.n0 >> 7) + 128 * (j.kind - 1));
                const unsigned char* base = (const unsigned char*)j.dst + (urow << sh) + j.k0;
#pragma unroll
                for (int ps = 0; ps < 4; ++ps) {
                    const int nr = ps * 64 + (ltv >> 2), slot = ltv & 3;
                    const u32x4 w = *(const LAS u32x4*)(img + ib * 32768 + nr * 64 + ((slot ^ ((nr >> 2) & 3)) * 16));
                    const long prow = j.kind == 3 ? (long)(ps * 64) : (long)(256 * (ps >> 1) + 64 * (ps & 1));
                    *(u32x4*)((unsigned char*)base + (prow << sh) + voff) = w;
                }
            } else if (tjob(jc, j)) {
                const int sh = __builtin_ctz((unsigned)j.ld_dst) + 1;
                const unsigned voff = (unsigned)(((ltv >> 3) << sh) + (ltv & 7) * 16);
                const unsigned char* base = (const unsigned char*)j.dst + ((long)j.n0 << sh) + j.k0 * 2;
#pragma unroll
                for (int ps = 0; ps < 8; ++ps) {
                    const int nr = ps * 32 + (ltv >> 3), slot = ltv & 7;
                    const u32x4 w = *(const LAS u32x4*)(img + ib * 32768 + nr * 128 + ((slot ^ ((nr >> 2) & 7)) * 16));
                    *(u32x4*)((unsigned char*)base + ((long)(ps * 32) << sh) + voff) = w;
                } }
        };
        auto lbody = [&](const int c, const int IB) {
            asm volatile("" : "+v"(ltv));
            twrite(tc, IB, true);
            __builtin_amdgcn_sched_barrier(0);
            tload(tc + 2, IB);
            __builtin_amdgcn_sched_barrier(0);
            tstore(tc - 1, IB ^ 1);
            __builtin_amdgcn_sched_barrier(0);
            if (c >= 2) asm volatile("s_waitcnt vmcnt(48)" ::: "memory"); else asm volatile("s_waitcnt vmcnt(0)" ::: "memory");
            gwrite(IB ^ 1, IB ^ 1);
            __builtin_amdgcn_sched_barrier(0);
            gload(c + 3 < 128 ? c + 3 : 127, IB ^ 1);
            flush(c > 0 ? c - 1 : 0, IB ^ 1);
            ++tc;
            scan_bar();
        };
        tload(0, 0); tload(1, 1);
        for (int u = 0; u < nunits; ++u) {
            const int bi = (int)blockIdx.x + u * (int)gridDim.x;
            const int L = (gridDim.x == 256) ? 2 * ((bi & 7) + 8 * (bi >> 4)) + ((bi >> 3) & 1) : bi;
            ub = L >> 6; uh = (L >> 2) & 15; uz = (L >> 1) & 1; uhalf = L & 1;
#pragma unroll
            for (int j = 0; j < 8; ++j) ka[j] = p.ab_k_a[uh * 64 + 8 * (ltv & 7) + j];
            gload(0, 0); asm volatile("s_waitcnt vmcnt(0)" ::: "memory"); gwrite(0, 0); gload(1, 1); gload(2, 0);
            scan_bar();
#pragma unroll 1
            for (int c = 0; c < 128; c += 2) { lbody(c, 0); lbody(c + 1, 1); }
            flush(127, 1);
        }
        tstore(tc - 1, 1); scan_bar();
        twrite(tc, 0); scan_bar();
        tstore(tc, 0); twrite(tc + 1, 1); scan_bar();
        tstore(tc + 1, 1);
    }
    __syncthreads();
}

DEV void phase_postscan(const Params& p, const int WV) {
    const int tid = opaque_tid(WV);
    const int c = 8 * (tid & 127);
    float lg[8], lb[8], ka[8], rk[8];
#pragma unroll
    for (int j = 0; j < 8; ++j) { lg[j] = p.ab_lnx_g[c + j]; lb[j] = p.ab_lnx_b[c + j]; ka[j] = p.ab_k_a[c + j]; rk[j] = p.ab_r_k[c + j]; }
#pragma unroll 2
    for (long row = (long)blockIdx.x * 4 + (tid >> 7); row < NTOK; row += (long)gridDim.x * 4) {
        float y[8], r[8], k[8], v[8], i0[8], i1[8], g[8];
        { float ya[8], yb[8]; unpack8(*(const u32x4*)(p.Y + row * 1024 + c), ya); unpack8(*(const u32x4*)(p.Y + ((long)NTOK + row) * 1024 + c), yb);
#pragma unroll
          for (int j = 0; j < 8; ++j) y[j] = ya[j] + yb[j]; }
        unpack8(*(const u32x4*)(p.R + row * 1024 + c), r); unpack8(*(const u32x4*)(p.K + row * 1024 + c), k); unpack8(*(const u32x4*)(p.V + row * 1024 + c), v);
        unpack8(*(const u32x4*)(p.iclr + (row * 2) * 1024 + c), i0); unpack8(*(const u32x4*)(p.iclr + (row * 2 + 1) * 1024 + c), i1); unpack8(*(const u32x4*)(p.G + row * 1024 + c), g);
        float s = 0.f, dot = 0.f;
#pragma unroll
        for (int j = 0; j < 8; ++j) { s += y[j]; dot += r[j] * k[j] * (2.0f + (i0[j] + i1[j] - 2.0f) * ka[j]) * rk[j]; }
        const float mu = xor_sum8(s) * (1.0f / 64.0f); dot = xor_sum8(dot);
        float q = 0.f;
#pragma unroll
        for (int j = 0; j < 8; ++j) { y[j] -= mu; q += y[j] * y[j]; }
        const float rstd = rsqrtf(xor_sum8(q) * (1.0f / 64.0f) + 6.4e-4f);
        float o[8];
#pragma unroll
        for (int j = 0; j < 8; ++j) o[j] = (y[j] * rstd * lg[j] + lb[j] + dot * v[j]) * g[j];
        *(u32x4*)(p.ycat + row * DM + 1024 + c) = pack8(o);
    }
}

template <int NJ, int W>
DEV void ln_row(float (&v)[NJ][W], const float* g, const float* b, int lane) {
    float s = 0.f;
#pragma unroll
    for (int j = 0; j < NJ; ++j)
#pragma unroll
        for (int i = 0; i < W; ++i) s += v[j][i];
    const float mean = wave_sum(s) * (1.0f / DM);
    float q = 0.f;
#pragma unroll
    for (int j = 0; j < NJ; ++j)
#pragma unroll
        for (int i = 0; i < W; ++i) { const float d = v[j][i] - mean; q += d * d; }
    const float rstd = rsqrtf(wave_sum(q) * (1.0f / DM) + 1e-5f);
#pragma unroll
    for (int j = 0; j < NJ; ++j) {
        const int col = W * (lane + 64 * j);
#pragma unroll
        for (int i4 = 0; i4 < W; i4 += 4) {
            const f32x4 g0 = *(const f32x4*)(g + col + i4), b0 = *(const f32x4*)(b + col + i4);
#pragma unroll
            for (int i = 0; i < 4; ++i) v[j][i4 + i] = (v[j][i4 + i] - mean) * rstd * g0[i] + b0[i];
        }
        asm volatile("" ::: "memory");
    }
}

DEV void phase_lnr(const Params& p, const int WV, int layer, const float* xin, LAS unsigned char* lds, bool dry = false) {
    const int TIDX = opaque_tid(WV);
    LAS float* tile = (LAS float*)lds;
    LAS float* part = (LAS float*)lds;
    LAS int* lcnt = (LAS int*)(lds + 16 * 2052 * 4);
    const int tid = TIDX, wid = tid >> 6, lane = tid & 63, fr = lane & 15, fq = lane >> 4;
    const float* lng = p.ln_mix_g + layer * DM; const float* lnb = p.ln_mix_b + layer * DM;
    const float* rw = p.router_w + (long)layer * DM * NEXP; const float* rb = p.router_b + layer * NEXP;
    const int m = 2 * layer + 1;
    if (tid < 64) lcnt[tid] = 0;
    __syncthreads();
    for (int grp = blockIdx.x; grp < NTOK / 16; grp += gridDim.x) {
        f32x4 xq[2][8]; u32x4 xb[2][4], tq[2][4];
#pragma unroll
        for (int rr = 0; rr < 2; ++rr) {
            const long row = (long)grp * 16 + 2 * wid + rr;
#pragma unroll
            for (int j = 0; j < 4; ++j) {
                const int col = 8 * (lane + 64 * j);
                if (layer == 0) { xq[rr][2 * j] = *(const f32x4*)(xin + row * DM + col); xq[rr][2 * j + 1] = *(const f32x4*)(xin + row * DM + col + 4); }
                else xb[rr][j] = *(const u32x4*)(p.X + row * DM + col);
                tq[rr][j] = *(const u32x4*)(p.T + row * DM + col);
            }
        }
#pragma unroll
        for (int rr = 0; rr < 2; ++rr) {
            const int rl = 2 * wid + rr; const long row = (long)grp * 16 + rl;
            float v[4][8];
#pragma unroll
            for (int j = 0; j < 4; ++j) {
                float xx[8];
                if (layer == 0) {
#pragma unroll
                    for (int i = 0; i < 4; ++i) { xx[i] = xq[rr][2 * j][i]; xx[4 + i] = xq[rr][2 * j + 1][i]; } }
                else unpack8(xb[rr][j], xx);
                float tt[8]; unpack8(tq[rr][j], tt);
#pragma unroll
                for (int i = 0; i < 8; ++i) v[j][i] = ALPHA * xx[i] + tt[i];
            }
            ln_row(v, lng, lnb, lane);
            const float* md = p.mod + ((long)m * 4 + (row >> 12)) * 6144;
#pragma unroll
            for (int j = 0; j < 4; ++j) {
                const int col = 8 * (lane + 64 * j);
                if (dry) { *(f32x4*)(p.out + row * DM + col) = (f32x4){v[j][0], v[j][1], v[j][2], v[j][3]}; *(f32x4*)(p.out + row * DM + col + 4) = (f32x4){v[j][4], v[j][5], v[j][6], v[j][7]}; }
                else *(u32x4*)(p.X + row * DM + col) = pack8(v[j]);
                float uu[8];
#pragma unroll
                for (int hh = 0; hh < 2; ++hh) {
                    const f32x4 sh = *(const f32x4*)(md + col + 4 * hh), sc = *(const f32x4*)(md + DM + col + 4 * hh);
#pragma unroll
                    for (int i = 0; i < 4; ++i) uu[4 * hh + i] = v[j][4 * hh + i] * (1.0f + sc[i]) + sh[i];
                }
                if (!dry) *(u32x2*)(p.U8 + row * DM + col) = (u32x2){pack4_fp8(uu[0], uu[1], uu[2], uu[3]), pack4_fp8(uu[4], uu[5], uu[6], uu[7])};
                *(LAS f32x4*)(tile + rl * 2052 + col) = (f32x4){uu[0], uu[1], uu[2], uu[3]};
                *(LAS f32x4*)(tile + rl * 2052 + col + 4) = (f32x4){uu[4], uu[5], uu[6], uu[7]};
            }
        }
        __syncthreads();
        f32x4 acc[4];
#pragma unroll
        for (int nt = 0; nt < 4; ++nt) acc[nt] = (f32x4){0.f, 0.f, 0.f, 0.f};
        float bwa[32], bwb[32];
        unsigned rvoff = (unsigned)(((256 * wid + 4 * fq) * NEXP + fr) * 4); asm volatile("" : "+v"(rvoff));
#define LNR_LD(dst, blk) do { _Pragma("unroll") for (int jj = 0; jj < 2; ++jj) { const char* rwj = (const char*)rw + (size_t)(16 * (2 * (blk) + jj)) * NEXP * 4; \
            _Pragma("unroll") for (int i = 0; i < 4; ++i) _Pragma("unroll") for (int nt = 0; nt < 4; ++nt) dst[16 * jj + 4 * i + nt] = *(const float*)(rwj + rvoff + (i * NEXP + 16 * nt) * 4); } } while (0)
#define LNR_MM(src, blk) do { _Pragma("unroll") for (int jj = 0; jj < 2; ++jj) { const f32x4 a4 = *(const LAS f32x4*)(tile + fr * 2052 + 256 * wid + 16 * (2 * (blk) + jj) + 4 * fq); \
            _Pragma("unroll") for (int i = 0; i < 4; ++i) _Pragma("unroll") for (int nt = 0; nt < 4; ++nt) acc[nt] = __builtin_amdgcn_mfma_f32_16x16x4f32(a4[i], src[16 * jj + 4 * i + nt], acc[nt], 0, 0, 0); } } while (0)
        LNR_LD(bwa, 0); __builtin_amdgcn_sched_barrier(0);
        LNR_LD(bwb, 1); LNR_MM(bwa, 0); __builtin_amdgcn_sched_barrier(0);
        LNR_LD(bwa, 2); LNR_MM(bwb, 1); __builtin_amdgcn_sched_barrier(0);
        LNR_LD(bwb, 3); LNR_MM(bwa, 2); __builtin_amdgcn_sched_barrier(0);
        LNR_LD(bwa, 4); LNR_MM(bwb, 3); __builtin_amdgcn_sched_barrier(0);
        LNR_LD(bwb, 5); LNR_MM(bwa, 4); __builtin_amdgcn_sched_barrier(0);
        LNR_LD(bwa, 6); LNR_MM(bwb, 5); __builtin_amdgcn_sched_barrier(0);
        LNR_LD(bwb, 7); LNR_MM(bwa, 6); __builtin_amdgcn_sched_barrier(0);
        LNR_MM(bwb, 7);
#undef LNR_LD
#undef LNR_MM
        __syncthreads();
#pragma unroll
        for (int nt = 0; nt < 4; ++nt)
#pragma unroll
            for (int r = 0; r < 4; ++r) part[(wid * 16 + 4 * fq + r) * 64 + 16 * nt + fr] = acc[nt][r];
        __syncthreads();
#pragma unroll 1
        for (int rr = 0; rr < 2; ++rr) {
            const int rl = 2 * wid + rr; const long tok = (long)grp * 16 + rl;
            float logit = 0.f;
#pragma unroll
            for (int w = 0; w < 8; ++w) logit += part[(w * 16 + rl) * 64 + lane];
            const float score = sigmoidf_(logit), biased = score + rb[lane];
            float m1 = biased; m1 = fmaxf(m1, SHFLX(m1, 1)); m1 = fmaxf(m1, SHFLX(m1, 2)); m1 = fmaxf(m1, SHFLX(m1, 4));
            const unsigned long long bal = __ballot(biased == m1);
            const int grp8 = lane >> 3; const unsigned gm = (unsigned)(bal >> (8 * grp8)) & 0xffu;
            const int first = 8 * grp8 + __builtin_ctz(gm);
            float v2 = (lane == first) ? -INFINITY : biased; v2 = fmaxf(v2, SHFLX(v2, 1)); v2 = fmaxf(v2, SHFLX(v2, 2)); v2 = fmaxf(v2, SHFLX(v2, 4));
            const float gs = m1 + v2;
            int grank = 0;
#pragma unroll
            for (int g2 = 0; g2 < 8; ++g2) { const float o = __int_as_float(__builtin_amdgcn_readlane(__float_as_int(gs), g2 * 8)); grank += (o > gs || (o == gs && g2 < grp8)) ? 1 : 0; }
            const float val = (grank < 4) ? biased : -INFINITY;
            int rank = 0;
#pragma unroll
            for (int e2 = 0; e2 < 64; ++e2) { const float o = __int_as_float(__builtin_amdgcn_readlane(__float_as_int(val), e2)); rank += (o > val || (o == val && e2 < lane)) ? 1 : 0; }
            const bool sel = (grank < 4) && (rank < 8);
            const float wsum = wave_sum(sel ? score : 0.f);
            if (sel && !dry) {
                const int pos = __hip_atomic_fetch_add((int*)(lcnt + lane), 1, __ATOMIC_RELAXED, __HIP_MEMORY_SCOPE_WORKGROUP);
                p.sel_e[tok * 8 + rank] = lane; p.sel_pos[tok * 8 + rank] = pos; p.sel_w[tok * 8 + rank] = score / wsum * 2.5f;
            }
        }
        __syncthreads();
    }
    if (tid < 64 && !dry) { const int base = atomicAdd(p.gcnt + layer * 64 + tid, lcnt[tid]); p.blockbase[blockIdx.x * 64 + tid] = base; }
}

DEV void phase_place(const Params& p, const int WV, int layer, LAS unsigned char* lds) {
    const int TIDX = opaque_tid(WV);
    LAS int* pstart = (LAS int*)lds;
    LAS int* cnts = (LAS int*)(lds + 512);
    const int tid = TIDX;
    if (tid < 64) cnts[tid] = p.gcnt[layer * 64 + tid];
    __syncthreads();
    if (tid == 0) { int s = 0; for (int e = 0; e < 64; ++e) { pstart[e] = s; s += (cnts[e] + 255) / 256 * 256; } pstart[64] = s; }
    __syncthreads();
    const int sh0 = pstart[64];
    if (blockIdx.x == 0) {
        if (tid == 0) { p.meta[0] = sh0 / 256 + 64; p.meta[1] = sh0; }
        for (int t = tid; t < sh0 / 256 + 64; t += NTHREADS) {
            int e = 64; const int r0 = t * 256;
            if (r0 < sh0) { e = 0; while (e < 63 && pstart[e + 1] <= r0) ++e; }
            p.tile_e[t] = e;
        }
    }
    for (int e = blockIdx.x; e < 64; e += gridDim.x) {
        const int beg = pstart[e] + cnts[e], end = pstart[e + 1];
        for (int r = beg + tid; r < end; r += NTHREADS) { p.row_src[r] = NTOK; p.row_dst[r] = NTOK * 9; p.row_g[r] = 0.f; p.row_rec[r] = (u32x2){(unsigned)(NTOK * 9), 0u}; }
    }
    for (int grp = blockIdx.x; grp < NTOK / 16; grp += gridDim.x) {
        if (tid < 128) {
            const int tok = grp * 16 + (tid >> 3), s = tid & 7;
            const int e = p.sel_e[tok * 8 + s], dest = pstart[e] + p.blockbase[blockIdx.x * 64 + e] + p.sel_pos[tok * 8 + s];
            const float gw = p.sel_w[tok * 8 + s]; p.row_src[dest] = tok; p.row_dst[dest] = tok * 9 + s; p.row_g[dest] = gw; p.row_rec[dest] = (u32x2){(unsigned)(tok * 9 + s), __float_as_uint(gw)};
        } else if (tid < 144) {
            const int tok = grp * 16 + (tid - 128);
            p.row_src[sh0 + tok] = tok; p.row_dst[sh0 + tok] = tok * 9 + 8; p.row_g[sh0 + tok] = 1.0f; p.row_rec[sh0 + tok] = (u32x2){(unsigned)(tok * 9 + 8), __float_as_uint(1.0f)};
        }
    }
}

DEV void phase_combine(const Params& p, const int WV, int layer, bool dry = false) {
    const int TIDX = opaque_tid(WV);
    const int lane = TIDX & 63; const long gw = (long)blockIdx.x * 8 + __builtin_amdgcn_readfirstlane(TIDX >> 6), nw = (long)gridDim.x * 8;
    const float* lng = p.ln_ffn_g + layer * DM; const float* lnb = p.ln_ffn_b + layer * DM;
    const int m = 2 * layer + 1;
    const int lane0 = lane;
    for (long row = gw; row < NTOK; row += nw) {
        int lane = lane0; asm volatile("" : "+v"(lane));
        const float* md = p.mod + ((long)m * 4 + (row >> 12)) * 6144;
        float v[2][16];
#pragma unroll
        for (int j = 0; j < 2; ++j) {
            const int col = 16 * (lane + 64 * j);
            float h[16];
#pragma unroll
            for (int i = 0; i < 16; ++i) h[i] = 0.f;
#pragma unroll
            for (int s = 0; s < 9; ++s) {
                const u32x4 w = *(const u32x4*)(p.slot + (row * 9 + s) * DM + col);
#pragma unroll
                for (int q = 0; q < 4; ++q) { const f32x2 lo = __builtin_amdgcn_cvt_pk_f32_fp8((int)w[q], false), hi = __builtin_amdgcn_cvt_pk_f32_fp8((int)w[q], true);
                    h[4 * q] += lo.x; h[4 * q + 1] += lo.y; h[4 * q + 2] += hi.x; h[4 * q + 3] += hi.y; }
            }
            if (DBG_ZERO & (layer ? 8 : 2)) {
#pragma unroll
                for (int i = 0; i < 16; ++i) h[i] = 0.f; }
#pragma unroll
            for (int i4 = 0; i4 < 16; i4 += 4) {
                const u32x2 xw = *(const u32x2*)(p.X + row * DM + col + i4); const f32x4 x0 = {bflo(xw.x), bfhi(xw.x), bflo(xw.y), bfhi(xw.y)}, g0 = *(const f32x4*)(md + 2 * DM + col + i4);
#pragma unroll
                for (int i = 0; i < 4; ++i) v[j][i4 + i] = ALPHA * x0[i] + (1.0f + g0[i]) * (h[i4 + i] * 0.015625f);
            }
            asm volatile("" : "+v"(v[j][0]), "+v"(v[j][1]), "+v"(v[j][2]), "+v"(v[j][3]), "+v"(v[j][4]), "+v"(v[j][5]), "+v"(v[j][6]), "+v"(v[j][7]),
                              "+v"(v[j][8]), "+v"(v[j][9]), "+v"(v[j][10]), "+v"(v[j][11]), "+v"(v[j][12]), "+v"(v[j][13]), "+v"(v[j][14]), "+v"(v[j][15]) :: "memory");
        }
        ln_row<2, 16>(v, lng, lnb, lane);
        const bool xbf = !dry && layer == 0;
        const float* md2 = p.mod + ((long)(2 * layer + 2) * 4 + (row >> 12)) * 6144;
#pragma unroll
        for (int j = 0; j < 2; ++j) {
            const int col = 16 * (lane + 64 * j);
#pragma unroll
            for (int i4 = 0; i4 < 16; i4 += 4) {
                if (xbf) *(u32x2*)(p.X + row * DM + col + i4) = (u32x2){cvt_pk_bf16(v[j][i4], v[j][i4 + 1]), cvt_pk_bf16(v[j][i4 + 2], v[j][i4 + 3])};
                else *(f32x4*)(p.out + row * DM + col + i4) = (f32x4){v[j][i4], v[j][i4 + 1], v[j][i4 + 2], v[j][i4 + 3]}; }
            if (layer == 0 && !dry) {
                u32x4 w8;
#pragma unroll
                for (int q4 = 0; q4 < 4; ++q4) {
                    const f32x4 sh = *(const f32x4*)(md2 + col + 4 * q4), sc = *(const f32x4*)(md2 + DM + col + 4 * q4);
                    w8[q4] = pack4_fp8(v[j][4 * q4] * (1.0f + sc[0]) + sh[0], v[j][4 * q4 + 1] * (1.0f + sc[1]) + sh[1], v[j][4 * q4 + 2] * (1.0f + sc[2]) + sh[2], v[j][4 * q4 + 3] * (1.0f + sc[3]) + sh[3]);
                }
                *(u32x4*)(p.U8 + row * DM + col) = w8;
            }
            asm volatile("" ::: "memory");
        }
    }
}

DEV void phase_combine_l1(const Params& p, const int WV, int layer, bool dry = false) {
    const int TIDX = opaque_tid(WV);
    const int lane = TIDX & 63; const long gw = (long)blockIdx.x * 8 + __builtin_amdgcn_readfirstlane(TIDX >> 6), nw = (long)gridDim.x * 8;
    const float* lng = p.ln_ffn_g + layer * DM; const float* lnb = p.ln_ffn_b + layer * DM;
    const int m = 2 * layer + 1;
    const int lane0 = lane;
    for (long row = gw; row < NTOK; row += nw) {
        int lane = opaque_lane();
        const float* md = p.mod + ((long)m * 4 + (row >> 12)) * 6144;
        u32x4 sq[2][9]; u32x2 xq[2][4]; f32x4 gq[2][4], lgq[2][4], lbq[2][4];
#pragma unroll
        for (int j = 0; j < 2; ++j) {
            const int col = 16 * (lane + 64 * j);
#pragma unroll
            for (int s = 0; s < 9; ++s) sq[j][s] = *(const u32x4*)(p.slot + (row * 9 + s) * DM + col);
        }
        float v[2][16];
        float ssum = 0.f;
#pragma unroll
        for (int j = 0; j < 2; ++j) {
#pragma unroll
            for (int i = 0; i < 16; ++i) v[j][i] = 0.f;
#pragma unroll
            for (int s = 0; s < 9; ++s) {
                const u32x4 w = sq[j][s];
#pragma unroll
                for (int q = 0; q < 4; ++q) { const f32x2 lo = __builtin_amdgcn_cvt_pk_f32_fp8((int)w[q], false), hi = __builtin_amdgcn_cvt_pk_f32_fp8((int)w[q], true);
                    v[j][4 * q] += lo.x; v[j][4 * q + 1] += lo.y; v[j][4 * q + 2] += hi.x; v[j][4 * q + 3] += hi.y; }
                if (s % 3 == 2) __builtin_amdgcn_sched_barrier(0);
            }
            if (DBG_ZERO & (layer ? 8 : 2)) {
#pragma unroll
                for (int i = 0; i < 16; ++i) v[j][i] = 0.f; }
            if (j == 0 && layer == 1) {
                __builtin_amdgcn_sched_barrier(0);
                asm volatile("" : "+v"(lane));
#pragma unroll
                for (int jj = 0; jj < 2; ++jj)
#pragma unroll
                    for (int q = 0; q < 4; ++q) { xq[jj][q] = *(const u32x2*)(p.X + row * DM + 16 * (lane + 64 * jj) + 4 * q); gq[jj][q] = *(const f32x4*)(md + 2 * DM + 16 * (lane + 64 * jj) + 4 * q); }
                __builtin_amdgcn_sched_barrier(0);
            }
        }
        if (layer == 0) {
            __builtin_amdgcn_sched_barrier(0);
            asm volatile("" : "+v"(lane));
#pragma unroll
            for (int jj = 0; jj < 2; ++jj)
#pragma unroll
                for (int q = 0; q < 4; ++q) { xq[jj][q] = *(const u32x2*)(p.X + row * DM + 16 * (lane + 64 * jj) + 4 * q); gq[jj][q] = *(const f32x4*)(md + 2 * DM + 16 * (lane + 64 * jj) + 4 * q); }
            __builtin_amdgcn_sched_barrier(0);
        }
#pragma unroll
        for (int j = 0; j < 2; ++j)
#pragma unroll
            for (int q = 0; q < 4; ++q) {
                const u32x2 xw = xq[j][q]; const f32x4 x0 = {bflo(xw.x), bfhi(xw.x), bflo(xw.y), bfhi(xw.y)}, g0 = gq[j][q];
#pragma unroll
                for (int i = 0; i < 4; ++i) { v[j][4 * q + i] = ALPHA * x0[i] + (1.0f + g0[i]) * (v[j][4 * q + i] * 0.015625f); ssum += v[j][4 * q + i]; }
            }
        __builtin_amdgcn_sched_barrier(0);
        asm volatile("" : "+v"(lane));
#pragma unroll
        for (int j = 0; j < 2; ++j)
#pragma unroll
            for (int q = 0; q < 4; ++q) { const int col = 16 * (lane + 64 * j); lgq[j][q] = *(const f32x4*)(lng + col + 4 * q); lbq[j][q] = *(const f32x4*)(lnb + col + 4 * q); }
        __builtin_amdgcn_sched_barrier(0);
        const float mean = wave_sum(ssum) * (1.0f / DM);
        float qsum = 0.f;
#pragma unroll
        for (int j = 0; j < 2; ++j)
#pragma unroll
            for (int i = 0; i < 16; ++i) { const float d = v[j][i] - mean; qsum += d * d; }
        const float rstd = rsqrtf(wave_sum(qsum) * (1.0f / DM) + 1e-5f);
#pragma unroll
        for (int j = 0; j < 2; ++j)
#pragma unroll
            for (int q = 0; q < 4; ++q)
#pragma unroll
                for (int i = 0; i < 4; ++i) v[j][4 * q + i] = (v[j][4 * q + i] - mean) * rstd * lgq[j][q][i] + lbq[j][q][i];
        __builtin_amdgcn_sched_barrier(0);
        asm volatile("" : "+v"(lane));
        const bool xbf = !dry && layer == 0;
        const float* md2 = p.mod + ((long)(2 * layer + 2) * 4 + (row >> 12)) * 6144;
#pragma unroll
        for (int j = 0; j < 2; ++j) {
            const int col = 16 * (lane + 64 * j);
#pragma unroll
            for (int i4 = 0; i4 < 16; i4 += 4) {
                if (xbf) *(u32x2*)(p.X + row * DM + col + i4) = (u32x2){cvt_pk_bf16(v[j][i4], v[j][i4 + 1]), cvt_pk_bf16(v[j][i4 + 2], v[j][i4 + 3])};
                else *(f32x4*)(p.out + row * DM + col + i4) = (f32x4){v[j][i4], v[j][i4 + 1], v[j][i4 + 2], v[j][i4 + 3]}; }
            if (layer == 0 && !dry) {
                u32x4 w8;
#pragma unroll
                for (int q4 = 0; q4 < 4; ++q4) {
                    const f32x4 sh = *(const f32x4*)(md2 + col + 4 * q4), sc = *(const f32x4*)(md2 + DM + col + 4 * q4);
                    w8[q4] = pack4_fp8(v[j][4 * q4] * (1.0f + sc[0]) + sh[0], v[j][4 * q4 + 1] * (1.0f + sc[1]) + sh[1], v[j][4 * q4 + 2] * (1.0f + sc[2]) + sh[2], v[j][4 * q4 + 3] * (1.0f + sc[3]) + sh[3]);
                }
                *(u32x4*)(p.U8 + row * DM + col) = w8;
            }
            asm volatile("" ::: "memory");
        }
    }
}

DEV void phase_attn(const Params& p, const int WV, LAS unsigned char* lds) {
    const int TIDX = opaque_tid(WV);
    constexpr int RS = 288;
    LAS unsigned char* Ks = lds; LAS unsigned char* Vs = lds + 256 * RS;
    const int tid = TIDX, wid = tid >> 6, lane = tid & 63, fr = lane & 15, fq = lane >> 4;
    const int qb = wid >> 2, wq = wid & 3;
    const int rq = 64 + 64 * qb + 16 * wq + fr;
    u32x4 kreg[8], vreg[8]; bf16x8 qn[4];
    auto load_unit = [&](int L) {
        const int su = L & 31, pat = (L >> 5) % 3, bh = L / 96, h = bh & 15, b = bh >> 4;
        const int d = pat == 0 ? 1 : (pat == 1 ? 4 : 16), Lr = SEQ / d, npair = Lr / 128, r = su / npair, n2 = su % npair, l0 = 128 * n2 - 64;
#pragma unroll
        for (int it = 0; it < 8; ++it) {
            const int ci = tid + 512 * it, row = ci >> 4, ch = ci & 15;
            int l = l0 + row; l = l < 0 ? 0 : (l > Lr - 1 ? Lr - 1 : l);
            const bf16_t* src = p.qkv + ((long)b * SEQ + (long)l * d + r) * 6144 + h * 128 + ch * 8;
            kreg[it] = *(const u32x4*)(src + 2048); vreg[it] = *(const u32x4*)(src + 4096);
        }
        const long qtok = (long)b * SEQ + (long)(l0 + rq) * d + r;
#pragma unroll
        for (int ks = 0; ks < 4; ++ks) qn[ks] = *(const bf16x8*)(p.qkv + qtok * 6144 + h * 128 + 32 * ks + 8 * fq);
    };
    if ((int)blockIdx.x < 4 * 16 * 3 * 32) load_unit(blockIdx.x);
    for (int L = blockIdx.x; L < 4 * 16 * 3 * 32; L += gridDim.x) {
        const int su = L & 31, pat = (L >> 5) % 3, bh = L / 96, h = bh & 15, b = bh >> 4;
        const int d = pat == 0 ? 1 : (pat == 1 ? 4 : 16), Lr = SEQ / d, npair = Lr / 128;
        const int r = su / npair, n2 = su % npair;
        const int l0 = 128 * n2 - 64;
        const long qtok = (long)b * SEQ + (long)(l0 + rq) * d + r;
#pragma unroll
        for (int it = 0; it < 8; ++it) {
            const int ci = tid + 512 * it, row = ci >> 4, ch = ci & 15;
            *(LAS u32x4*)(Ks + row * RS + ch * 16) = kreg[it]; *(LAS u32x4*)(Vs + row * RS + ch * 16) = vreg[it];
        }
        bf16x8 qf[4];
#pragma unroll
        for (int ks = 0; ks < 4; ++ks) qf[ks] = qn[ks];
        __syncthreads();
        if (L + (int)gridDim.x < 4 * 16 * 3 * 32) load_unit(L + gridDim.x);
        f32x4 s[12];
#pragma unroll
        for (int kt = 0; kt < 12; ++kt) {
            s[kt] = (f32x4){0.f, 0.f, 0.f, 0.f};
#pragma unroll
            for (int ks = 0; ks < 4; ++ks) {
                const bf16x8 kf = *(const LAS bf16x8*)(Ks + (64 * qb + 16 * kt + fr) * RS + ks * 64 + fq * 16);
                s[kt] = __builtin_amdgcn_mfma_f32_16x16x32_bf16(kf, qf[ks], s[kt], 0, 0, 0);
            }
        }
        const float slope = exp2f(-0.5f * (float)(h + 1)) * (float)d;
        float mx = -3.0e38f;
        int rkb = 64 * qb + 4 * fq - rq;
        asm volatile("" : "+v"(rkb));
#pragma unroll
        for (int kt = 0; kt < 12; ++kt)
#pragma unroll
            for (int j = 0; j < 4; ++j) {
                const int dk = rkb + 16 * kt + j, rel = dk < 0 ? -dk : dk, lk = l0 + rq + dk;
                const bool valid = (rel <= 64) && (lk >= 0) && (lk < Lr);
                const float v = valid ? (s[kt][j] - slope * (float)rel) : -1.0e30f;
                s[kt][j] = v; mx = fmaxf(mx, v);
            }
        mx = fmaxf(mx, SHFLX(mx, 16)); mx = fmaxf(mx, SHFLX(mx, 32));
        float sum = 0.f;
#pragma unroll
        for (int kt = 0; kt < 12; ++kt)
#pragma unroll
            for (int j = 0; j < 4; ++j) { const float e = __expf(s[kt][j] - mx); s[kt][j] = e; sum += e; }
        sum += SHFLX(sum, 16); sum += SHFLX(sum, 32);
        f32x4 o[8];
#pragma unroll
        for (int dt = 0; dt < 8; ++dt) o[dt] = (f32x4){0.f, 0.f, 0.f, 0.f};
        const int q4 = fr >> 2, p4 = fr & 3;
#pragma unroll
        for (int ks = 0; ks < 6; ++ks) {
            union { bf16x8 v; unsigned w[4]; } pf;
            pf.w[0] = cvt_pk_bf16(s[2 * ks][0], s[2 * ks][1]); pf.w[1] = cvt_pk_bf16(s[2 * ks][2], s[2 * ks][3]);
            pf.w[2] = cvt_pk_bf16(s[2 * ks + 1][0], s[2 * ks + 1][1]); pf.w[3] = cvt_pk_bf16(s[2 * ks + 1][2], s[2 * ks + 1][3]);
            const int krow = 64 * qb + 32 * ks + 4 * fq + q4;
            const unsigned a0 = (unsigned)(size_t)(Vs + krow * RS + 8 * p4);
            u32x2 vh[16];
            asm volatile(
                "ds_read_b64_tr_b16 %0, %16 offset:0\n\tds_read_b64_tr_b16 %1, %16 offset:4608\n\t"
                "ds_read_b64_tr_b16 %2, %16 offset:32\n\tds_read_b64_tr_b16 %3, %16 offset:4640\n\t"
                "ds_read_b64_tr_b16 %4, %16 offset:64\n\tds_read_b64_tr_b16 %5, %16 offset:4672\n\t"
                "ds_read_b64_tr_b16 %6, %16 offset:96\n\tds_read_b64_tr_b16 %7, %16 offset:4704\n\t"
                "ds_read_b64_tr_b16 %8, %16 offset:128\n\tds_read_b64_tr_b16 %9, %16 offset:4736\n\t"
                "ds_read_b64_tr_b16 %10, %16 offset:160\n\tds_read_b64_tr_b16 %11, %16 offset:4768\n\t"
                "ds_read_b64_tr_b16 %12, %16 offset:192\n\tds_read_b64_tr_b16 %13, %16 offset:4800\n\t"
                "ds_read_b64_tr_b16 %14, %16 offset:224\n\tds_read_b64_tr_b16 %15, %16 offset:4832\n\t"
                "s_waitcnt lgkmcnt(0)"
                : "=&v"(vh[0]), "=&v"(vh[1]), "=&v"(vh[2]), "=&v"(vh[3]), "=&v"(vh[4]), "=&v"(vh[5]), "=&v"(vh[6]), "=&v"(vh[7]),
                  "=&v"(vh[8]), "=&v"(vh[9]), "=&v"(vh[10]), "=&v"(vh[11]), "=&v"(vh[12]), "=&v"(vh[13]), "=&v"(vh[14]), "=&v"(vh[15])
                : "v"(a0) : "memory");
#pragma unroll
            for (int dt = 0; dt < 8; ++dt) {
                union { bf16x8 v; u32x2 h[2]; } vf; vf.h[0] = vh[2 * dt]; vf.h[1] = vh[2 * dt + 1];
                o[dt] = __builtin_amdgcn_mfma_f32_16x16x32_bf16(vf.v, pf.v, o[dt], 0, 0, 0);
            }
        }
        const float inv = 1.0f / sum;
        bf16_t* op = p.op + ((long)pat * NTOK + qtok) * DM + h * 128;
#pragma unroll
        for (int dt = 0; dt < 8; ++dt) {
            u32x2 w; w.x = cvt_pk_bf16(o[dt][0] * inv, o[dt][1] * inv); w.y = cvt_pk_bf16(o[dt][2] * inv, o[dt][3] * inv);
            *(u32x2*)(op + 16 * dt + 4 * fq) = w;
        }
        if (fq == 0) p.lse[((long)pat * NTOK + qtok) * 16 + h] = mx + __logf(sum);
        __syncthreads();
    }
}
DEV void phase_merge(const Params& p, const int WV) {
    const int TIDX = opaque_tid(WV);
    const long gtid = (long)blockIdx.x * NTHREADS + TIDX, gsz = (long)gridDim.x * NTHREADS;
    for (long i = gtid; i < (long)NTOK * DM / 8; i += gsz) {
        const long row = i >> 8; const int col = (int)(i & 255) * 8, h = col >> 7;
        const float l0 = p.lse[row * 16 + h], l1 = p.lse[((long)NTOK + row) * 16 + h], l2 = p.lse[(2L * NTOK + row) * 16 + h];
        const float mx = fmaxf(l0, fmaxf(l1, l2)); float w0 = __expf(l0 - mx), w1 = __expf(l1 - mx), w2 = __expf(l2 - mx);
        const float inv = 1.0f / (w0 + w1 + w2); w0 *= inv; w1 *= inv; w2 *= inv;
        float a[8], b[8], c[8], o[8];
        unpack8(*(const u32x4*)(p.op + row * DM + col), a); unpack8(*(const u32x4*)(p.op + ((long)NTOK + row) * DM + col), b); unpack8(*(const u32x4*)(p.op + (2L * NTOK + row) * DM + col), c);
#pragma unroll
        for (int j = 0; j < 8; ++j) o[j] = w0 * a[j] + w1 * b[j] + w2 * c[j];
        *(u32x4*)(p.ocat + row * DM + col) = pack8(o);
    }
}


DEV void phase_attn_naive(const Params& p, const int WV) {
    const int TIDX = opaque_tid(WV);
    const int lane = TIDX & 63; const long gw = (long)blockIdx.x * 8 + __builtin_amdgcn_readfirstlane(TIDX >> 6), nw = (long)gridDim.x * 8;
    for (long it = gw; it < (long)NTOK * 16; it += nw) {
        const long tok = it >> 4; const int h = (int)(it & 15), b = (int)(tok >> 12), t = (int)(tok & 4095);
        const unsigned qw = *(const unsigned*)(p.qkv + tok * 6144 + h * 128 + 2 * lane);
        const float q0 = bflo(qw), q1 = bfhi(qw);
        float m = -3.0e38f, l = 0.f, o0 = 0.f, o1 = 0.f;
        const float slope = exp2f(-0.5f * (float)(h + 1));
        for (int pat = 0; pat < 3; ++pat) {
            const int d = pat == 0 ? 1 : (pat == 1 ? 4 : 16), Lr = SEQ / d, r = t % d, lq = t / d;
            for (int j = -64; j <= 64; ++j) {
                const int lk = lq + j; if (lk < 0 || lk >= Lr) continue;
                const long kt = (long)b * SEQ + (long)lk * d + r;
                const unsigned kw = *(const unsigned*)(p.qkv + kt * 6144 + 2048 + h * 128 + 2 * lane);
                const unsigned vw = *(const unsigned*)(p.qkv + kt * 6144 + 4096 + h * 128 + 2 * lane);
                const float sc = wave_sum(q0 * bflo(kw) + q1 * bfhi(kw)) - slope * (float)(d * (j < 0 ? -j : j));
                const float mn = fmaxf(m, sc), f = __expf(m - mn), pe = __expf(sc - mn);
                l = l * f + pe; o0 = o0 * f + pe * bflo(vw); o1 = o1 * f + pe * bfhi(vw); m = mn;
            }
        }
        *(unsigned*)(p.ocat + tok * DM + h * 128 + 2 * lane) = cvt_pk_bf16(o0 / l, o1 / l);
    }
}


DEV void phase_attn_check(const Params& p, const int WV) {
    const int TIDX = opaque_tid(WV);
    const int lane = TIDX & 63; const long gw = (long)blockIdx.x * 8 + __builtin_amdgcn_readfirstlane(TIDX >> 6), nw = (long)gridDim.x * 8;
    for (long it = gw; it < (long)NTOK * 16; it += nw) {
        const long tok = it >> 4; const int h = (int)(it & 15), b = (int)(tok >> 12), t = (int)(tok & 4095);
        const unsigned qw = *(const unsigned*)(p.qkv + tok * 6144 + h * 128 + 2 * lane);
        const float q0 = bflo(qw), q1 = bfhi(qw);
        const float slope = exp2f(-0.5f * (float)(h + 1));
        for (int pat = 0; pat < 3; ++pat) {
            float m = -3.0e38f, l = 0.f, o0 = 0.f, o1 = 0.f;
            const int d = pat == 0 ? 1 : (pat == 1 ? 4 : 16), Lr = SEQ / d, r = t % d, lq = t / d;
            for (int j = -64; j <= 64; ++j) {
                const int lk = lq + j; if (lk < 0 || lk >= Lr) continue;
                const long kt = (long)b * SEQ + (long)lk * d + r;
                const unsigned kw = *(const unsigned*)(p.qkv + kt * 6144 + 2048 + h * 128 + 2 * lane);
                const unsigned vw = *(const unsigned*)(p.qkv + kt * 6144 + 4096 + h * 128 + 2 * lane);
                const float sc = wave_sum(q0 * bflo(kw) + q1 * bfhi(kw)) - slope * (float)(d * (j < 0 ? -j : j));
                const float mn = fmaxf(m, sc), f = __expf(m - mn), pe = __expf(sc - mn);
                l = l * f + pe; o0 = o0 * f + pe * bflo(vw); o1 = o1 * f + pe * bfhi(vw); m = mn;
            }
            const unsigned ow = *(const unsigned*)(p.op + ((long)pat * NTOK + tok) * DM + h * 128 + 2 * lane);
            const float e0 = fabsf(bflo(ow) - o0 / l), e1 = fabsf(bfhi(ow) - o1 / l);
            const float le = fabsf(p.lse[((long)pat * NTOK + tok) * 16 + h] - (m + __logf(l)));
            const bool bad_o = !(e0 < 0.05f && e1 < 0.05f), bad_l = !(le < 0.05f);
            if (__ballot(bad_o) && lane == 0) atomicOr((unsigned*)p.meta + 8, 1u << pat);
            if (bad_l && lane == 0) atomicOr((unsigned*)p.meta + 8, 8u << pat);
        }
    }
}


DEV void phase_merge_check(const Params& p, const int WV) {
    const int TIDX = opaque_tid(WV);
    const int lane = TIDX & 63; const long gw = (long)blockIdx.x * 8 + __builtin_amdgcn_readfirstlane(TIDX >> 6), nw = (long)gridDim.x * 8;
    for (long it = gw; it < (long)NTOK * 16; it += nw) {
        const long tok = it >> 4; const int h = (int)(it & 15), b = (int)(tok >> 12), t = (int)(tok & 4095);
        const unsigned qw = *(const unsigned*)(p.qkv + tok * 6144 + h * 128 + 2 * lane);
        const float q0 = bflo(qw), q1 = bfhi(qw);
        float m = -3.0e38f, l = 0.f, o0 = 0.f, o1 = 0.f;
        const float slope = exp2f(-0.5f * (float)(h + 1));
        for (int pat = 0; pat < 3; ++pat) {
            const int d = pat == 0 ? 1 : (pat == 1 ? 4 : 16), Lr = SEQ / d, r = t % d, lq = t / d;
            for (int j = -64; j <= 64; ++j) {
                const int lk = lq + j; if (lk < 0 || lk >= Lr) continue;
                const long kt = (long)b * SEQ + (long)lk * d + r;
                const unsigned kw = *(const unsigned*)(p.qkv + kt * 6144 + 2048 + h * 128 + 2 * lane);
                const unsigned vw = *(const unsigned*)(p.qkv + kt * 6144 + 4096 + h * 128 + 2 * lane);
                const float sc = wave_sum(q0 * bflo(kw) + q1 * bfhi(kw)) - slope * (float)(d * (j < 0 ? -j : j));
                const float mn = fmaxf(m, sc), f = __expf(m - mn), pe = __expf(sc - mn);
                l = l * f + pe; o0 = o0 * f + pe * bflo(vw); o1 = o1 * f + pe * bfhi(vw); m = mn;
            }
        }
        const float l0 = p.lse[tok * 16 + h], l1 = p.lse[((long)NTOK + tok) * 16 + h], l2 = p.lse[(2L * NTOK + tok) * 16 + h];
        const float mx = fmaxf(l0, fmaxf(l1, l2)); float w0 = __expf(l0 - mx), w1 = __expf(l1 - mx), w2 = __expf(l2 - mx);
        const float inv = 1.0f / (w0 + w1 + w2); w0 *= inv; w1 *= inv; w2 *= inv;
        const unsigned a = *(const unsigned*)(p.op + tok * DM + h * 128 + 2 * lane), bb = *(const unsigned*)(p.op + ((long)NTOK + tok) * DM + h * 128 + 2 * lane), c = *(const unsigned*)(p.op + (2L * NTOK + tok) * DM + h * 128 + 2 * lane);
        const float m0 = w0 * bflo(a) + w1 * bflo(bb) + w2 * bflo(c), m1 = w0 * bfhi(a) + w1 * bfhi(bb) + w2 * bfhi(c);
        const float e0 = fabsf(m0 - o0 / l), e1 = fabsf(m1 - o1 / l);
        float em = wave_max(fmaxf(e0, e1)); if (!(em < 0.9f)) em = 0.9f;
        if (lane == 0) atomicMax((unsigned*)p.meta + 8, __float_as_uint(em));
    }
}

template <int PH> DEV void run_phase(const Params& p, const int WV, LAS unsigned char* lds) {
    if constexpr (PH == 0) phase_prologue(p, WV, lds);
    if constexpr (PH == 1) phase_modulate(p, WV, p.x, 0);
    if constexpr (PH == 2) { EpiBf16 E{p.proj, INP, 0, 1.0f}; phase_gemm_plain(lds, WV, p.U, DM, p.wt_in, DM, NTOK, INP, DM, INP, E); }
    if constexpr (PH == 3) { phase_fold(p, WV); phase_rwkv_prep(p, WV); }
    if constexpr (PH == 4) { EpiLoraWA E{p.omw, p.iclr, p.ab_w0, p.ab_a0}; phase_gemm_plain(lds, WV, p.alora, 512, p.wl_wa, 256, NTOK, 4096, 256, 0, E);
                             phase_fourier1(p, WV, lds); phase_wn(p, WV);
                             EpiBf16 E2{p.G, 1024, 0, 1.0f}; phase_gemm_plain(lds, WV, p.alora + 256, 512, p.wl_g, 256, NTOK, 1024, 256, 1024, E2); }
    if constexpr (PH == 5) { phase_scan(p, WV, lds); phase_fourier2(p, WV, lds); phase_nyquist(p, WV); }
    if constexpr (PH == 6) { phase_postscan(p, WV); phase_unfold(p, WV); }
    if constexpr (PH == 7) { EpiResid E{p.mod + 0 * 4 * 6144 + 4096, p.T, (DBG_ZERO & 1) ? 0.f : 1.f}; phase_gemm_plain(lds, WV, p.ycat, DM, p.wt_out0, DM, NTOK, DM, DM, DM, E); }
    if constexpr (PH == 8) { if (DBG_DRY & 1) { phase_lnr(p, WV, 0, p.x, lds, true); __syncthreads(); } phase_lnr(p, WV, 0, p.x, lds); }
    if constexpr (PH == 9) phase_place(p, WV, 0, lds);
    if constexpr (PH == 10) phase_moe1(p, WV, 0, lds);
    if constexpr (PH == 11) phase_moe2(p, WV, 0, lds);
    if constexpr (PH == 12) { if (DBG_DRY & 2) phase_combine(p, WV, 0, true); phase_combine(p, WV, 0); }
    if constexpr (PH == 13) { EpiBf16 E{p.qkv, 6144, 2048, 0.08838834764831845f}; phase_gemm_plain<1>(lds, WV, (const bf16_t*)p.U8, DM, p.wt_qkv, DM, NTOK, 6144, DM, 6144, E); }
#if DBG_NAIVE_ATTN == 3
    if constexpr (PH == 14) { phase_attn(p, WV, lds); }
    if constexpr (PH == 15) { phase_attn_check(p, WV); phase_attn_naive(p, WV); }
#elif DBG_NAIVE_ATTN == 2
    if constexpr (PH == 14) { phase_attn(p, WV, lds); phase_attn_naive(p, WV); }
    if constexpr (PH == 15) phase_attn_check(p, WV);
#elif DBG_NAIVE_ATTN
    if constexpr (PH == 14) phase_attn_naive(p, WV);
#else
    if constexpr (PH == 14) phase_attn(p, WV, lds);
    if constexpr (PH == 15) phase_merge(p, WV);
#endif
    if constexpr (PH == 16) { EpiResid E{p.mod + 2 * 4 * 6144 + 4096, p.T, (DBG_ZERO & 4) ? 0.f : 1.f}; phase_gemm_plain(lds, WV, p.ocat, DM, p.wt_o1, DM, NTOK, DM, DM, DM, E); }
    if constexpr (PH == 17) phase_lnr(p, WV, 1, nullptr, lds);
    if constexpr (PH == 18) phase_place(p, WV, 1, lds);
    if constexpr (PH == 19) phase_moe1(p, WV, 1, lds);
    if constexpr (PH == 20) phase_moe2(p, WV, 1, lds);
    if constexpr (PH == 21) phase_combine_l1(p, WV, 1);
}
constexpr int NPHASES = 22;

extern __shared__ __attribute__((aligned(16))) unsigned char dyn_lds[];

template <int PH> __global__ void __launch_bounds__(NTHREADS, 2) k_phase(Params p) {
    const int WV = __builtin_amdgcn_readfirstlane(threadIdx.x >> 6);
    run_phase<PH>(p, WV, (LAS unsigned char*)dyn_lds);
}
template <int PH> DEV void run_from(const Params& p, const int WV, LAS unsigned char* lds, const XcdBarrier& bar) {
    if constexpr (PH == 5 && (DBG_DRY & 8) != 0) { phase_scan(p, WV, lds, p.meta[0] >= -5); xcd_barrier(bar); }
    if constexpr (PH == 11 && (DBG_DRY & 4) != 0) { phase_moe2(p, WV, 0, lds, p.meta[0] >= 0); xcd_barrier(bar); }
    run_phase<PH>(p, WV, lds);
    if constexpr ((DBG_REPEAT_MASK >> PH) & 1) { xcd_barrier(bar); run_phase<PH>(p, WV, lds); }
    if constexpr (PH + 1 < NPHASES) { xcd_barrier(bar); run_from<PH + 1>(p, WV, lds, bar); }
}
__global__ void __launch_bounds__(NTHREADS, 2) k_mega(Params p) {
    const int WV = __builtin_amdgcn_readfirstlane(threadIdx.x >> 6);
    LAS unsigned char* lds = (LAS unsigned char*)dyn_lds;
    volatile LAS unsigned* st = (volatile LAS unsigned*)(lds + LDS_BYTES - 16);
    if (threadIdx.x == 0) { st[0] = 0u; st[1] = 0u; st[2] = 0u; st[3] = 0u; }
    __syncthreads();
    const XcdBarrier bar = xcd_barrier_post(p.bar, st);
    run_from<0>(p, WV, lds, bar);
}

template <int PH> static void launch_phase(const Params& p, int grid, hipStream_t stream) {
    static bool attr = false;
    if (!attr) { (void)hipFuncSetAttribute((const void*)k_phase<PH>, hipFuncAttributeMaxDynamicSharedMemorySize, LDS_BYTES); attr = true; }
    hipLaunchKernelGGL(k_phase<PH>, dim3(grid), dim3(NTHREADS), LDS_BYTES, stream, p);
}
template <int PH> static void launch_all(const Params& p, int grid, hipStream_t stream) {
    launch_phase<PH>(p, grid, stream);
    if constexpr (PH + 1 < NPHASES) launch_all<PH + 1>(p, grid, stream);
}

extern "C" void kernel_launch(void* const* d_in, const int* in_sizes, int n_in, void* d_out, int out_size, void* d_ws, size_t ws_size, hipStream_t stream) {
    (void)in_sizes; (void)n_in; (void)out_size;
    Params p{};
    const float** ins = (const float**)&p.x;
    for (int i = 0; i < 34; ++i) ins[i] = (const float*)d_in[i];
    p.out = (float*)d_out;
    size_t off = 0;
    auto take = [&](size_t bytes) { void* r = (char*)d_ws + off; off += (bytes + 255) & ~(size_t)255; return r; };
    p.bar = (unsigned*)take(XCD_BAR_WORDS * 4);
    p.gcnt = (int*)take(128 * 4); p.blockbase = (int*)take(256 * 64 * 4); p.meta = (int*)take(64); p.tile_e = (int*)take((RMAX / 256 + 8) * 4);
    p.sel_e = (int*)take((size_t)NTOK * 8 * 4); p.sel_pos = (int*)take((size_t)NTOK * 8 * 4); p.sel_w = (float*)take((size_t)NTOK * 8 * 4);
    p.row_src = (int*)take((size_t)RMAX * 4); p.row_dst = (int*)take((size_t)RMAX * 4); p.row_g = (float*)take((size_t)RMAX * 4); p.row_rec = (u32x2*)take((size_t)RMAX * 8);
    p.mod = (float*)take(4 * 4 * 6144 * 4);
    p.wt_in = (bf16_t*)take((size_t)INP * DM * 2); p.wt_out0 = (bf16_t*)take((size_t)DM * DM * 2); p.wt_qkv = (bf16_t*)take((size_t)3 * DM * DM * 2); p.wt_o1 = (bf16_t*)take((size_t)DM * DM * 2);
    p.w1 = (unsigned char*)take((size_t)130 * 1024 * DM); p.U8 = (unsigned char*)take((size_t)(NTOK + 256) * DM); p.w2 = (bf16_t*)take((size_t)130 * DM * DEXP * 2);
    p.wl_wa = (bf16_t*)take(4096 * 256 * 2); p.wl_g = (bf16_t*)take(1024 * 256 * 2); p.dft1 = (bf16_t*)take(2 * 256 * 256 * 2); p.dft2 = (bf16_t*)take((size_t)2 * 2048 * 2048 * 2); p.wn = (float*)take(4096 * 4);
    p.U = (bf16_t*)take((size_t)(NTOK + 256) * DM * 2); p.X = (bf16_t*)take((size_t)NTOK * DM * 2);
    p.H = (bf16_t*)take((size_t)RMAX * DEXP * 2); p.T = p.H;
    const size_t big0 = off;
    p.slot = (unsigned char*)take(((size_t)NTOK * 9 + 1) * DM);
    const size_t big_end_slot = off; off = big0;
    p.proj = (bf16_t*)take((size_t)NTOK * INP * 2); p.wtf = (bf16_t*)take((size_t)4 * 1024 * 4096 * 2); p.zf = (bf16_t*)take((size_t)4 * 2 * 2048 * 1024 * 2); p.pq = (bf16_t*)take((size_t)4 * 2 * 2048 * 1024 * 2);
    p.R = (bf16_t*)take((size_t)NTOK * 1024 * 2); p.K = (bf16_t*)take((size_t)NTOK * 1024 * 2); p.V = (bf16_t*)take((size_t)NTOK * 1024 * 2); p.KK = (bf16_t*)take((size_t)NTOK * 1024 * 2);
    p.alora = (bf16_t*)take((size_t)NTOK * 512 * 2); p.omw = (bf16_t*)take((size_t)NTOK * 2048 * 2); p.iclr = (bf16_t*)take((size_t)NTOK * 2048 * 2); p.G = (bf16_t*)take((size_t)NTOK * 1024 * 2);
    p.Y = (bf16_t*)take((size_t)2 * NTOK * 1024 * 2); p.ycat = (bf16_t*)take((size_t)NTOK * DM * 2);
    const size_t big_end_mix0 = off; off = big0;
    p.qkv = (bf16_t*)take((size_t)NTOK * 6144 * 2); p.op = (bf16_t*)take((size_t)3 * NTOK * DM * 2); p.lse = (float*)take((size_t)3 * NTOK * 16 * 4); p.ocat = (bf16_t*)take((size_t)NTOK * DM * 2);
    const size_t big_end_mix1 = off;
    off = big_end_slot > big_end_mix0 ? big_end_slot : big_end_mix0; if (big_end_mix1 > off) off = big_end_mix1;
    if (off > ws_size) fprintf(stderr, "kernel_launch: workspace too small: need %zu have %zu\n", off, ws_size);
    (void)hipMemsetAsync(p.bar, 0, XCD_BAR_WORDS * 4, stream);
#if MK_MULTI
    launch_all<0>(p, 256, stream);
#else
    static int grid = 0;
    if (!grid) {
        int dev = 0, cus = 0, per_cu = 0;
        (void)hipGetDevice(&dev);
        (void)hipDeviceGetAttribute(&cus, hipDeviceAttributeMultiprocessorCount, dev);
        (void)hipFuncSetAttribute((const void*)k_mega, hipFuncAttributeMaxDynamicSharedMemorySize, LDS_BYTES);
        (void)hipOccupancyMaxActiveBlocksPerMultiprocessor(&per_cu, k_mega, NTHREADS, LDS_BYTES);
        grid = cus * (per_cu < 1 ? per_cu : 1);
        if (grid <= 0) { fprintf(stderr, "kernel_launch: occupancy query says 0 blocks per CU\n"); grid = 1; }
    }
    hipLaunchKernelGGL(k_mega, dim3(grid), dim3(NTHREADS), LDS_BYTES, stream, p);
#endif
}
```

```cpp
#include <hip/hip_runtime.h>
#include <stdint.h>
#include <stdio.h>

#ifndef DBG_ZERO
#define DBG_ZERO 0
#endif
#ifndef DBG_NAIVE_ATTN
#define DBG_NAIVE_ATTN 0
#endif
#ifndef GEMM_FAST
#define GEMM_FAST 1
#endif
#ifndef DBG_REPEAT_MASK
#define DBG_REPEAT_MASK 0
#endif
#ifndef DBG_DRY
#define DBG_DRY 0
#endif
#ifndef MOE2_STAGGER
#define MOE2_STAGGER 0
#endif
#ifndef CONV_IN_SCAN
#define CONV_IN_SCAN 1
#endif
#ifndef MK_MULTI
#define MK_MULTI 0
#endif

typedef unsigned short bf16_t;
typedef short bf16x8 __attribute__((ext_vector_type(8)));
typedef float f32x4 __attribute__((ext_vector_type(4)));
typedef float f32x2 __attribute__((ext_vector_type(2)));
typedef unsigned u32x4 __attribute__((ext_vector_type(4)));
typedef unsigned u32x2 __attribute__((ext_vector_type(2)));
#define DEV __device__ __forceinline__
#define LAS __attribute__((address_space(3)))

constexpr int NTOK = 16384, DM = 2048, SEQ = 4096, NBATCH = 4;
constexpr int INP = 4608;
constexpr int IN_AB = 4512, IN_B = 3488;
constexpr int NEXP = 64, DEXP = 512;
constexpr int RMAX = 131072 + 64 * 256 + 16384;
constexpr int NTHREADS = 512;
constexpr int LDS_BYTES = 160 * 1024;
constexpr float ALPHA = 1.41421356237f;

struct Params {
    const float *x, *c, *ab_w_in, *ab_mu_prev, *ab_mu_next, *ab_w0, *ab_w_up, *ab_a0, *ab_a_up, *ab_g_up, *ab_k_k, *ab_k_a, *ab_r_k,
        *ab_lnx_g, *ab_lnx_b, *ab_w_out, *dsa_w_qkv, *dsa_w_out, *ada_mix_w, *ada_mix_b, *ln_mix_g, *ln_mix_b, *ada_ffn_w, *ada_ffn_b,
        *ln_ffn_g, *ln_ffn_b, *router_w, *router_b, *exp_gate, *exp_up, *exp_down, *sh_gate, *sh_up, *sh_down;
    float* out;
    unsigned* bar;
    int* gcnt;
    int* blockbase;
    int* meta;
    int* tile_e;
    int *sel_e, *sel_pos; float* sel_w;
    int *row_src, *row_dst; float* row_g;
    u32x2* row_rec;
    float* mod;
    bf16_t *wt_in, *wt_out0, *wt_qkv, *wt_o1, *w2, *wl_wa, *wl_g, *dft1, *dft2;
    unsigned char* w1;
    unsigned char* U8;
    bf16_t* U;
    bf16_t* X;
    bf16_t* T;
    bf16_t* H;
    bf16_t *proj, *wtf, *zf, *pq, *R, *K, *V, *KK, *alora, *omw, *iclr, *G, *ycat;
    float* wn;
    bf16_t* Y;
    bf16_t *qkv, *op, *ocat; float* lse;
    unsigned char* slot;
};

DEV float bf2f(bf16_t v) { return __uint_as_float((unsigned)v << 16); }
typedef __bf16 bf16x2_t __attribute__((ext_vector_type(2)));
DEV unsigned cvt_pk_bf16(float lo, float hi) { const f32x2 v = {lo, hi}; return __builtin_bit_cast(unsigned, __builtin_convertvector(v, bf16x2_t)); }
DEV unsigned pack4_fp8(float a, float b, float c, float d) {
    int v = __builtin_amdgcn_cvt_pk_fp8_f32(a, b, 0, false); return (unsigned)__builtin_amdgcn_cvt_pk_fp8_f32(c, d, v, true);
}
DEV bf16_t f2bf(float x) { return (bf16_t)(cvt_pk_bf16(x, 0.f) & 0xffffu); }
DEV float bflo(unsigned w) { return __uint_as_float(w << 16); }
DEV float bfhi(unsigned w) { return __uint_as_float(w & 0xffff0000u); }
DEV void unpack8(const u32x4 w, float (&f)[8]) { f[0] = bflo(w.x); f[1] = bfhi(w.x); f[2] = bflo(w.y); f[3] = bfhi(w.y); f[4] = bflo(w.z); f[5] = bfhi(w.z); f[6] = bflo(w.w); f[7] = bfhi(w.w); }
DEV u32x4 pack8(const float (&f)[8]) { u32x4 w; w.x = cvt_pk_bf16(f[0], f[1]); w.y = cvt_pk_bf16(f[2], f[3]); w.z = cvt_pk_bf16(f[4], f[5]); w.w = cvt_pk_bf16(f[6], f[7]); return w; }
DEV int opaque_lane() { unsigned z = 0u; asm volatile("" : "+s"(z)); return (int)__builtin_amdgcn_mbcnt_hi(~0u, __builtin_amdgcn_mbcnt_lo(~0u, z)); }
DEV float shfl_xor_l(float v, int o, int l) { return __builtin_bit_cast(float, __builtin_amdgcn_ds_bpermute((l ^ o) << 2, __builtin_bit_cast(int, v))); }
#define SHFLX(v, o) shfl_xor_l((v), (o), opaque_lane())
DEV float wave_sum(float v) {
    const int l = opaque_lane();
#pragma unroll
    for (int o = 32; o >= 1; o >>= 1) v += shfl_xor_l(v, o, l);
    return v;
}
DEV float wave_max(float v) {
    const int l = opaque_lane();
#pragma unroll
    for (int o = 32; o >= 1; o >>= 1) v = fmaxf(v, shfl_xor_l(v, o, l));
    return v;
}
template <int CTRL> DEV float dpp_mov(float x) { return __builtin_bit_cast(float, __builtin_amdgcn_update_dpp(0, __builtin_bit_cast(int, x), CTRL, 0xF, 0xF, true)); }
DEV float dpp_sum16(float x) { x += dpp_mov<0xB1>(x); x += dpp_mov<0x4E>(x); x += dpp_mov<0x141>(x); x += dpp_mov<0x140>(x); return x; }
DEV int opaque_tid(int wv) { unsigned z = 0u; asm volatile("" : "+s"(z)); int t = (wv << 6) | (int)__builtin_amdgcn_mbcnt_hi(~0u, __builtin_amdgcn_mbcnt_lo(~0u, z)); asm volatile("" : "+v"(t)); return t; }
DEV void dpp_sum16_pair(float& a, float& b) {
    asm volatile(
        "s_nop 1\n\t"
        "v_add_f32_dpp %0, %0, %0 quad_perm:[1,0,3,2] row_mask:0xf bank_mask:0xf bound_ctrl:1\n\t"
        "v_add_f32_dpp %1, %1, %1 quad_perm:[1,0,3,2] row_mask:0xf bank_mask:0xf bound_ctrl:1\n\t"
        "s_nop 0\n\t"
        "v_add_f32_dpp %0, %0, %0 quad_perm:[2,3,0,1] row_mask:0xf bank_mask:0xf bound_ctrl:1\n\t"
        "v_add_f32_dpp %1, %1, %1 quad_perm:[2,3,0,1] row_mask:0xf bank_mask:0xf bound_ctrl:1\n\t"
        "s_nop 0\n\t"
        "v_add_f32_dpp %0, %0, %0 row_half_mirror row_mask:0xf bank_mask:0xf bound_ctrl:1\n\t"
        "v_add_f32_dpp %1, %1, %1 row_half_mirror row_mask:0xf bank_mask:0xf bound_ctrl:1\n\t"
        "s_nop 0\n\t"
        "v_add_f32_dpp %0, %0, %0 row_mirror row_mask:0xf bank_mask:0xf bound_ctrl:1\n\t"
        "v_add_f32_dpp %1, %1, %1 row_mirror row_mask:0xf bank_mask:0xf bound_ctrl:1\n\t"
        "s_nop 1"
        : "+v"(a), "+v"(b));
}
DEV void dpp_sum16_quad(float& a, float& b, float& c, float& d, const f32x2 pa, const f32x2 pb, const f32x2 pc, const f32x2 pd) {
    asm volatile(
        "v_add_f32 %0, %4, %5\n\t"
        "v_add_f32 %1, %6, %7\n\t"
        "v_add_f32 %2, %8, %9\n\t"
        "v_add_f32 %3, %10, %11\n\t"
        "v_add_f32_dpp %0, %0, %0 quad_perm:[1,0,3,2] row_mask:0xf bank_mask:0xf bound_ctrl:1\n\t"
        "v_add_f32_dpp %1, %1, %1 quad_perm:[1,0,3,2] row_mask:0xf bank_mask:0xf bound_ctrl:1\n\t"
        "v_add_f32_dpp %2, %2, %2 quad_perm:[1,0,3,2] row_mask:0xf bank_mask:0xf bound_ctrl:1\n\t"
        "v_add_f32_dpp %3, %3, %3 quad_perm:[1,0,3,2] row_mask:0xf bank_mask:0xf bound_ctrl:1\n\t"
        "v_add_f32_dpp %0, %0, %0 quad_perm:[2,3,0,1] row_mask:0xf bank_mask:0xf bound_ctrl:1\n\t"
        "v_add_f32_dpp %1, %1, %1 quad_perm:[2,3,0,1] row_mask:0xf bank_mask:0xf bound_ctrl:1\n\t"
        "v_add_f32_dpp %2, %2, %2 quad_perm:[2,3,0,1] row_mask:0xf bank_mask:0xf bound_ctrl:1\n\t"
        "v_add_f32_dpp %3, %3, %3 quad_perm:[2,3,0,1] row_mask:0xf bank_mask:0xf bound_ctrl:1\n\t"
        "v_add_f32_dpp %0, %0, %0 row_half_mirror row_mask:0xf bank_mask:0xf bound_ctrl:1\n\t"
        "v_add_f32_dpp %1, %1, %1 row_half_mirror row_mask:0xf bank_mask:0xf bound_ctrl:1\n\t"
        "v_add_f32_dpp %2, %2, %2 row_half_mirror row_mask:0xf bank_mask:0xf bound_ctrl:1\n\t"
        "v_add_f32_dpp %3, %3, %3 row_half_mirror row_mask:0xf bank_mask:0xf bound_ctrl:1\n\t"
        "v_add_f32_dpp %0, %0, %0 row_mirror row_mask:0xf bank_mask:0xf bound_ctrl:1\n\t"
        "v_add_f32_dpp %1, %1, %1 row_mirror row_mask:0xf bank_mask:0xf bound_ctrl:1\n\t"
        "v_add_f32_dpp %2, %2, %2 row_mirror row_mask:0xf bank_mask:0xf bound_ctrl:1\n\t"
        "v_add_f32_dpp %3, %3, %3 row_mirror row_mask:0xf bank_mask:0xf bound_ctrl:1"
        : "=&v"(a), "=&v"(b), "=&v"(c), "=&v"(d)
        : "v"(pa.x), "v"(pa.y), "v"(pb.x), "v"(pb.y), "v"(pc.x), "v"(pc.y), "v"(pd.x), "v"(pd.y));
}
DEV float sigmoidf_(float x) { return __builtin_amdgcn_rcpf(1.0f + __expf(-x)); }
DEV float siluf_(float x) { return x * __builtin_amdgcn_rcpf(1.0f + __expf(-x)); }

#define XB_TMO      128
#define XB_XCNT(j)  (256  + 64 * (j))
#define XB_XSUB(j)  (1280 + 64 * (j))
#define XB_XGEN(j)  (2304 + 64 * (j))
#define XB_TOP      3328
#define XB_TOPGEN   3392
#define XCD_BAR_WORDS 3456
#define XB_SPIN_CAP (1u << 18)
__device__ __forceinline__ unsigned xb_ld(unsigned* p)              { return __hip_atomic_load(p, __ATOMIC_RELAXED, __HIP_MEMORY_SCOPE_AGENT); }
__device__ __forceinline__ unsigned xb_add(unsigned* p, unsigned v) { return __hip_atomic_fetch_add(p, v, __ATOMIC_RELAXED, __HIP_MEMORY_SCOPE_AGENT); }
__device__ __forceinline__ unsigned xb_xcc_id() { return (unsigned)__builtin_amdgcn_s_getreg((3 << 11) | 20) & 0xFu; }
#define XB_SPIN(cond, bar) do { unsigned _sp = 0; while (cond) { __builtin_amdgcn_s_sleep(1); \
    if ((++_sp & 255u) == 0u) { if (xb_ld(&(bar)[XB_TMO])) break; if (_sp > XB_SPIN_CAP) { atomicAdd(&(bar)[XB_TMO], 1u); break; } } } } while (0)
struct XcdBarrier { unsigned* bar; unsigned x; volatile LAS unsigned* st; };
__device__ __forceinline__ XcdBarrier xcd_barrier_post(unsigned* bar, volatile LAS unsigned* st) {
    XcdBarrier b; b.bar = bar; b.x = xb_xcc_id(); b.st = st;
    if (threadIdx.x == 0) (void)xb_add(&bar[XB_XCNT(b.x)], 1u);
    return b;
}
__device__ __forceinline__ void xcd_barrier_complete(unsigned* bar, unsigned x, unsigned& nloc, unsigned& nx) {
    const unsigned G = gridDim.x * gridDim.y * gridDim.z;
    unsigned sum, cnt, mine, sp = 0u;
    for (;;) {
        sum = 0u; cnt = 0u; mine = 0u;
#pragma unroll
        for (unsigned j = 0; j < 16; ++j) { const unsigned c = xb_ld(&bar[XB_XCNT(j)]); sum += c; cnt += (c > 0u) ? 1u : 0u; mine = (j == x) ? c : mine; }
        if (sum == G) break;
        __builtin_amdgcn_s_sleep(1);
        if ((++sp & 255u) == 0u) { if (xb_ld(&bar[XB_TMO])) break; if (sp > XB_SPIN_CAP) { atomicAdd(&bar[XB_TMO], 1u); break; } }
    }
    nloc = mine > 0u ? mine : 1u; nx = cnt > 0u ? cnt : 1u;
}
__device__ __forceinline__ void xcd_barrier(const XcdBarrier& b) {
    asm volatile("s_waitcnt vmcnt(0)" ::: "memory");
    __syncthreads();
    if (threadIdx.x == 0) {
        unsigned* bar = b.bar;
        __builtin_amdgcn_s_waitcnt(0);
        unsigned nloc = b.st[0], nx = b.st[1];
        if (nloc == 0u) { xcd_barrier_complete(bar, b.x, nloc, nx); b.st[0] = nloc; b.st[1] = nx; }
        const unsigned old = xb_add(&bar[XB_XSUB(b.x)], 1u);
        const unsigned gen = old / nloc;
        if (old + 1u == (gen + 1u) * nloc) {
            __builtin_amdgcn_fence(__ATOMIC_RELEASE, "agent");
            asm volatile("s_waitcnt vmcnt(0)" ::: "memory");
            const unsigned og = xb_add(&bar[XB_TOP], 1u);
            const unsigned tg = og / nx;
            if (og + 1u == (tg + 1u) * nx) xb_add(&bar[XB_TOPGEN], 1u);
            else XB_SPIN(xb_ld(&bar[XB_TOPGEN]) == tg, bar);
            __builtin_amdgcn_fence(__ATOMIC_ACQUIRE, "agent");
            xb_add(&bar[XB_XGEN(b.x)], 1u);
            asm volatile("s_waitcnt vmcnt(0)" ::: "memory");
        } else {
            XB_SPIN(xb_ld(&bar[XB_XGEN(b.x)]) == gen, bar);
            __builtin_amdgcn_fence(__ATOMIC_ACQUIRE, "agent");
            asm volatile("s_waitcnt vmcnt(0)" ::: "memory");
        }
    }
    __syncthreads();
}

struct Unit { const bf16_t* A; const int* arow; const bf16_t* Bt; int pm, pn, e; long ooff; const void* tab; int tsel; };
DEV int perm32(int rho) { const int n = rho >> 4, i = rho & 15; return 8 * (i >> 2) + 4 * n + (i & 3); }

template <class Epi>
DEV void gemm_tile_simple(const Unit& u, long lda, long ldb, int K, const Epi& E) {
    const int tid = threadIdx.x, wid = __builtin_amdgcn_readfirstlane(tid >> 6), lane = tid & 63, wr = wid >> 2, wc = wid & 3, fr = lane & 15, fq = lane >> 4;
    f32x4 acc[2][2][4][2];
#pragma unroll
    for (int a = 0; a < 2; ++a)
#pragma unroll
        for (int b = 0; b < 2; ++b)
#pragma unroll
            for (int m = 0; m < 4; ++m)
#pragma unroll
                for (int n = 0; n < 2; ++n) acc[a][b][m][n] = (f32x4){0.f, 0.f, 0.f, 0.f};
    unsigned ao[2][4];
#pragma unroll
    for (int ai = 0; ai < 2; ++ai)
#pragma unroll
        for (int m = 0; m < 4; ++m) {
            const int r = 128 * ai + 64 * wr + 16 * m + fr;
            ao[ai][m] = (unsigned)((u.arow ? (long)u.arow[r] : (long)r) * lda + 8 * fq);
        }
    unsigned bo[2][2];
#pragma unroll
    for (int bj = 0; bj < 2; ++bj)
#pragma unroll
        for (int n = 0; n < 2; ++n) {
            const int rr = Epi::PERM ? perm32(16 * n + fr) : (16 * n + fr);
            bo[bj][n] = (unsigned)((long)(128 * bj + 32 * wc + rr) * ldb + 8 * fq);
        }
#pragma unroll 1
    for (int k0 = 0; k0 < K; k0 += 32) {
        bf16x8 af[2][4], bfr[2][2];
#pragma unroll
        for (int ai = 0; ai < 2; ++ai)
#pragma unroll
            for (int m = 0; m < 4; ++m) af[ai][m] = *(const bf16x8*)(u.A + k0 + ao[ai][m]);
#pragma unroll
        for (int bj = 0; bj < 2; ++bj)
#pragma unroll
            for (int n = 0; n < 2; ++n) bfr[bj][n] = *(const bf16x8*)(u.Bt + k0 + bo[bj][n]);
#pragma unroll
        for (int ai = 0; ai < 2; ++ai)
#pragma unroll
            for (int bj = 0; bj < 2; ++bj)
#pragma unroll
                for (int m = 0; m < 4; ++m)
#pragma unroll
                    for (int n = 0; n < 2; ++n) acc[ai][bj][m][n] = __builtin_amdgcn_mfma_f32_16x16x32_bf16(bfr[bj][n], af[ai][m], acc[ai][bj][m][n], 0, 0, 0);
    }
    E(acc, u, wr, wc, fr, fq);
}

struct EpiBf16 {
    static constexpr bool PERM = true; static constexpr int BMAP = 0;
    bf16_t* O; long ldo; int qcols; float qs;
    DEV void operator()(const f32x4 (&acc)[2][2][4][2], const Unit& u, int wr, int wc, int fr, int fq) const {
#pragma unroll
        for (int ai = 0; ai < 2; ++ai)
#pragma unroll
            for (int m = 0; m < 4; ++m) {
                bf16_t* rowp = O + u.ooff + (long)(128 * ai + 64 * wr + 16 * m + fr) * ldo + 32 * wc + 8 * fq;
#pragma unroll
                for (int bj = 0; bj < 2; ++bj) {
                    const float sc = (256 * u.pn < qcols) ? qs : 1.0f;
                    const f32x4 v0 = acc[ai][bj][m][0] * sc, v1 = acc[ai][bj][m][1] * sc;
                    u32x4 w; w.x = cvt_pk_bf16(v0[0], v0[1]); w.y = cvt_pk_bf16(v0[2], v0[3]); w.z = cvt_pk_bf16(v1[0], v1[1]); w.w = cvt_pk_bf16(v1[2], v1[3]);
                    *(u32x4*)(rowp + 128 * bj) = w;
                }
            }
    }
};
struct EpiLoraWA {
    static constexpr bool PERM = true; static constexpr int BMAP = 0;
    bf16_t *omw, *iclr; const float *w0, *a0;
    DEV void operator()(const f32x4 (&acc)[2][2][4][2], const Unit& u, int wr, int wc, int fr, int fq) const {
        const int colt = 256 * u.pn, type = colt >> 11, z = (colt >> 10) & 1;
        const float* bias = (type ? a0 : w0) + z * 1024;
        bf16_t* O = type ? iclr : omw;
        const int c0 = (colt & 1023) + 32 * wc + 8 * fq;
        f32x4 bv[2][2];
#pragma unroll
        for (int bj = 0; bj < 2; ++bj)
#pragma unroll
            for (int n = 0; n < 2; ++n) bv[bj][n] = *(const f32x4*)(bias + c0 + 128 * bj + 4 * n);
#pragma unroll
        for (int ai = 0; ai < 2; ++ai)
#pragma unroll
            for (int m = 0; m < 4; ++m) {
                const long row = 256L * u.pm + 128 * ai + 64 * wr + 16 * m + fr;
#pragma unroll
                for (int bj = 0; bj < 2; ++bj) {
                    float o[8];
#pragma unroll
                    for (int n = 0; n < 2; ++n)
#pragma unroll
                        for (int j = 0; j < 4; ++j) {
                            const float sg = sigmoidf_(acc[ai][bj][m][n][j] + bv[bj][n][j]);
                            o[4 * n + j] = type ? sg : (1.0f - __expf(-0.60653065971f * sg));
                        }
                    *(u32x4*)(O + (row * 2 + z) * 1024 + c0 + 128 * bj) = pack8(o);
                }
                __builtin_amdgcn_sched_barrier(0);
            }
    }
};
struct EpiResid {
    static constexpr bool PERM = true; static constexpr int BMAP = 0;
    const float* gate; bf16_t* T; float hs;
    DEV void operator()(const f32x4 (&acc)[2][2][4][2], const Unit& u, int wr, int wc, int fr, int fq) const {
#pragma unroll
        for (int ai = 0; ai < 2; ++ai)
#pragma unroll
            for (int m = 0; m < 4; ++m) {
                const long row = 256L * u.pm + 128 * ai + 64 * wr + 16 * m + fr;
                const float* gp = gate + (row >> 12) * 6144;
#pragma unroll
                for (int bj = 0; bj < 2; ++bj) {
                    const int col = 256 * u.pn + 128 * bj + 32 * wc + 8 * fq;
                    const f32x4 g0 = *(const f32x4*)(gp + col), g1 = *(const f32x4*)(gp + col + 4);
                    float o[8];
#pragma unroll
                    for (int j = 0; j < 4; ++j) { o[j] = (1.0f + g0[j]) * (acc[ai][bj][m][0][j] * hs); o[4 + j] = (1.0f + g1[j]) * (acc[ai][bj][m][1][j] * hs); }
                    *(u32x4*)(T + row * DM + col) = pack8(o);
                }
            }
    }
};
struct EpiMoe1 {
    static constexpr bool PERM = true; static constexpr int BMAP = 0;
    bf16_t* H;
    DEV void operator()(const f32x4 (&acc)[2][2][4][2], const Unit& u, int wr, int wc, int fr, int fq) const {
#pragma unroll
        for (int ai = 0; ai < 2; ++ai)
#pragma unroll
            for (int m = 0; m < 4; ++m) {
                const long row = 256L * u.pm + 128 * ai + 64 * wr + 16 * m + fr;
                float o[8];
#pragma unroll
                for (int n = 0; n < 2; ++n)
#pragma unroll
                    for (int j = 0; j < 4; ++j) o[4 * n + j] = siluf_(acc[ai][0][m][n][j]) * acc[ai][1][m][n][j];
                *(u32x4*)(H + row * DEXP + 128 * u.pn + 32 * wc + 8 * fq) = pack8(o);
                __builtin_amdgcn_sched_barrier(0);
            }
    }
};
struct EpiMoe2 {
    static constexpr bool PERM = true; static constexpr int BMAP = 1;
    unsigned char* slot; LAS const unsigned char* ltab; bool skip;
    DEV void operator()(const f32x4 (&acc)[2][2][4][2], const Unit& u, int wr, int wc, int fr, int fq) const {
#pragma unroll
        for (int ai = 0; ai < 2; ++ai)
#pragma unroll
            for (int m = 0; m < 4; ++m) {
                const int rl = 128 * ai + 64 * wr + 16 * m + fr;
                const u32x2 rec = *(LAS const u32x2*)(ltab + (u.tsel * 256 + rl) * 8);
                const float g = __uint_as_float(rec.y) * 64.0f;
                u32x4 w;
#pragma unroll
                for (int bj = 0; bj < 2; ++bj)
#pragma unroll
                    for (int n = 0; n < 2; ++n) {
                        const f32x4 t = acc[ai][bj][m][n] * g;
                        float o[4];
#pragma unroll
                        for (int j = 0; j < 4; ++j) o[j] = __builtin_amdgcn_fmed3f(t[j], -440.f, 440.f);
                        w[2 * bj + n] = pack4_fp8(o[0], o[1], o[2], o[3]);
                    }
                long dst = rec.x; if (skip) dst = (256L * u.pm + rl) % 147456;
                *(u32x4*)(slot + dst * DM + 256 * u.pn + 64 * wc + 16 * fq) = w;
            }
    }
};

constexpr int HTB = 128 * 64 * 2;
DEV int lds_byte(int r, int c) { const int st = (r >> 4) * 2 + (c >> 5), rr = r & 15, cc = c & 31, ob = rr * 64 + cc * 2; return st * 1024 + (ob ^ (((ob >> 9) & 1) << 5)); }
DEV void stage_rc(int b, int& R, int& C) { const int st = b / 1024, sb = b % 1024, swz = sb ^ (((sb >> 9) & 1) << 5); R = (st >> 1) * 16 + swz / 64; C = (st & 1) * 32 + (swz % 64) / 2; }

template <int TAB, int ESZ, class Epi, class Sched>
DEV void gemm_phase_fast(LAS unsigned char* lds, const int wv, const long lda, const long ldb, const int K, const Sched& S, const Epi& E) {
    const int tid = opaque_tid(wv);
    const int wid = __builtin_amdgcn_readfirstlane(tid >> 6), lane = tid & 63, wr = wid >> 2, wc = wid & 3, fr = lane & 15, fq = lane >> 4;
    const int nt = K * ESZ / 128;
    constexpr bool GATHER = (TAB == 1);
    LAS unsigned char* tabl = lds + 131072;
    int sR[2], sC[2];
    unsigned voffB[2], voffB1[2], vA0[2], vA1[2], nA0[2], nA1[2];
#pragma unroll
    for (int i = 0; i < 2; ++i) { stage_rc(tid * 16 + i * 8192, sR[i], sC[i]); const int pr = Epi::PERM ? perm32(sR[i] & 31) : (sR[i] & 31);
        const int R0 = Epi::BMAP == 1 ? (64 * (sR[i] >> 5) + 16 * (pr >> 3) + (pr & 7)) : (32 * (sR[i] >> 5) + pr), R1 = Epi::BMAP == 1 ? (R0 + 8) : (R0 + 128);
        voffB[i] = (unsigned)((long)R0 * ldb * ESZ + 2 * sC[i]); voffB1[i] = (unsigned)((long)R1 * ldb * ESZ + 2 * sC[i]); }
    const size_t kstep = 128;
    const unsigned ldsw = (unsigned)wid * 1024u;
    const int aoff = ESZ == 2 ? lds_byte(wr * 64 + fr, fq * 8) : lds_byte(wr * 64 + fr, fq * 16), boff = ESZ == 2 ? lds_byte(wc * 32 + fr, fq * 8) : lds_byte(wc * 32 + fr, fq * 16);
#define PG8_SA(b, h) (((b) * 2 + (h)) * HTB)
#define PG8_SB(b, h) ((4 + (b) * 2 + (h)) * HTB)
#define PG8_STAGE(bufoff, gbase, voff) do { _Pragma("unroll") for (int _i = 0; _i < 2; ++_i) \
        __builtin_amdgcn_global_load_lds((const unsigned*)((const char*)(gbase) + (voff)[_i]), (LAS unsigned*)(lds + (bufoff) + ldsw + _i * 8192), 16, 0, 0); } while (0)
#define PG8_LDA(dst, b, h) do { _Pragma("unroll") for (int m = 0; m < 4; ++m) { \
        if constexpr (ESZ == 2) { _Pragma("unroll") for (int k = 0; k < 2; ++k) dst[m][k] = *(const LAS bf16x8*)(lds + PG8_SA(b, h) + aoff + m * 2048 + k * 1024); } \
        else { const i32x4 _lo = *(const LAS i32x4*)(lds + PG8_SA(b, h) + aoff + m * 2048), _hi = *(const LAS i32x4*)(lds + PG8_SA(b, h) + aoff + m * 2048 + 16); \
               dst##8[m] = __builtin_shufflevector(_lo, _hi, 0, 1, 2, 3, 4, 5, 6, 7); } } } while (0)
#define PG8_LDB(dst, b, h) do { _Pragma("unroll") for (int n = 0; n < 2; ++n) { \
        if constexpr (ESZ == 2) { _Pragma("unroll") for (int k = 0; k < 2; ++k) dst[n][k] = *(const LAS bf16x8*)(lds + PG8_SB(b, h) + boff + n * 2048 + k * 1024); } \
        else { const i32x4 _lo = *(const LAS i32x4*)(lds + PG8_SB(b, h) + boff + n * 2048), _hi = *(const LAS i32x4*)(lds + PG8_SB(b, h) + boff + n * 2048 + 16); \
               dst##8[n] = __builtin_shufflevector(_lo, _hi, 0, 1, 2, 3, 4, 5, 6, 7); } } } while (0)
#define PG8_MMA(ai, bj, At, Bt) do { __builtin_amdgcn_s_setprio(1); _Pragma("unroll") for (int m = 0; m < 4; ++m) _Pragma("unroll") for (int n = 0; n < 2; ++n) { \
        if constexpr (ESZ == 2) { _Pragma("unroll") for (int k = 0; k < 2; ++k) acc[ai][bj][m][n] = __builtin_amdgcn_mfma_f32_16x16x32_bf16(Bt[n][k], At[m][k], acc[ai][bj][m][n], 0, 0, 0); } \
        else asm volatile("v_mfma_scale_f32_16x16x128_f8f6f4 %0, %1, %2, %0, %3, %4 op_sel_hi:[0,0,0]" : "+v"(acc[ai][bj][m][n]) : "v"(Bt##8[n]), "v"(At##8[m]), "v"(mxscale_w), "v"(mxscale)); } \
        __builtin_amdgcn_s_setprio(0); } while (0)
#define PG8_WAIT_V(n) asm volatile("s_waitcnt vmcnt(" #n ")" ::: "memory")
#define PG8_WAIT_L(n) asm volatile("s_waitcnt lgkmcnt(" #n ")" ::: "memory")
#define PG8_BAR __builtin_amdgcn_s_barrier()
#define PG8_SCHED __builtin_amdgcn_sched_barrier(0)
#define PG8_AOFFS(u, o0, o1) do { _Pragma("unroll") for (int _i = 0; _i < 2; ++_i) { \
        const long _r0 = GATHER ? (long)*(LAS const int*)(tabl + ((u).tsel * 256 + sR[_i]) * 8) : (long)sR[_i], _r1 = GATHER ? (long)*(LAS const int*)(tabl + ((u).tsel * 256 + 128 + sR[_i]) * 8) : (long)(128 + sR[_i]); \
        o0[_i] = (unsigned)(_r0 * lda * ESZ + 2 * sC[_i]); o1[_i] = (unsigned)(_r1 * lda * ESZ + 2 * sC[_i]); } } while (0)
    Unit cur, nxt; int ui = 0;
    if (!S.next(0, cur)) return;
    f32x4 acc[2][2][4][2];
#pragma unroll
    for (int a = 0; a < 2; ++a)
#pragma unroll
        for (int b = 0; b < 2; ++b)
#pragma unroll
            for (int m = 0; m < 4; ++m)
#pragma unroll
                for (int n = 0; n < 2; ++n) acc[a][b][m][n] = (f32x4){0.f, 0.f, 0.f, 0.f};
    typedef int i32x8 __attribute__((ext_vector_type(8))); typedef int i32x4 __attribute__((ext_vector_type(4)));
    bf16x8 At[4][2], B0[2][2], B1[2][2];
    const int mxscale = 0x7F7F7F7F, mxscale_w = 0x7A7A7A7A;
    i32x8 At8[4], B08[2], B18[2];
    const char* cA = (const char*)cur.A; const char* cB = (const char*)cur.Bt;
    cur.tsel = 0;
    if (TAB) {
        if (tid < 256) { if (TAB == 1) *(LAS int*)(tabl + tid * 8) = ((const int*)cur.tab)[tid]; else *(LAS u32x2*)(tabl + tid * 8) = ((const u32x2*)cur.tab)[tid]; }
        __syncthreads();
    }
    PG8_AOFFS(cur, vA0, vA1);
    PG8_STAGE(PG8_SB(0, 0), cB, voffB); PG8_STAGE(PG8_SA(0, 0), cA, vA0); PG8_STAGE(PG8_SB(0, 1), cB, voffB1); PG8_STAGE(PG8_SA(0, 1), cA, vA1);
    if (wr == 1) PG8_BAR;
    PG8_WAIT_V(4); PG8_BAR;
    PG8_STAGE(PG8_SB(1, 0), cB + kstep, voffB); PG8_STAGE(PG8_SA(1, 0), cA + kstep, vA0); PG8_STAGE(PG8_SB(1, 1), cB + kstep, voffB1);
    PG8_WAIT_V(6); PG8_BAR;
    for (;;) {
        const bool has_next = S.next(ui + 1, nxt);
        const char* nA = has_next ? (const char*)nxt.A : cA; const char* nB = has_next ? (const char*)nxt.Bt : cB;
        nxt.tsel = (ui + 1) & 1;
        if (GATHER) {
#pragma unroll
            for (int i = 0; i < 2; ++i) { nA0[i] = vA0[i]; nA1[i] = vA1[i]; } }
#pragma unroll 1
        for (int t = 0; t < nt; t += 2) {
            const bool last = (t == nt - 2);
            const bool tabtrip = TAB && has_next && (t == nt - 4) && (tid < 256);
            u32x2 tq;
            if (tabtrip) { const unsigned long long tp = (unsigned long long)nxt.tab;
                           const unsigned long long tps = ((unsigned long long)(unsigned)__builtin_amdgcn_readfirstlane((int)(tp >> 32)) << 32) | (unsigned)__builtin_amdgcn_readfirstlane((int)tp);
                           if (TAB == 1) asm volatile("s_nop 4\n\tglobal_load_dword %0, %1, %2" : "=v"(tq.x) : "v"(tid * 4), "s"(tps) : "memory");
                           else asm volatile("s_nop 4\n\tglobal_load_dwordx2 %0, %1, %2" : "=v"(tq) : "v"(tid * 8), "s"(tps) : "memory"); }
            const char* a1 = cA + (size_t)(t + 1) * kstep;
            const char* a2 = last ? nA : cA + (size_t)(t + 2) * kstep; const char* b2 = last ? nB : cB + (size_t)(t + 2) * kstep;
            const char* a3 = a2 + kstep; const char* b3 = b2 + kstep;
            PG8_LDB(B0, 0, 0); PG8_SCHED; PG8_LDA(At, 0, 0); PG8_STAGE(PG8_SA(1, 1), a1, vA1);
            PG8_WAIT_L(8); PG8_BAR; PG8_WAIT_L(0); PG8_MMA(0, 0, At, B0); PG8_BAR; PG8_SCHED;
            PG8_LDB(B1, 0, 1); PG8_STAGE(PG8_SB(0, 0), b2, voffB);
            PG8_BAR; PG8_WAIT_L(0); PG8_MMA(0, 1, At, B1); PG8_BAR;
            if (GATHER && last && has_next) PG8_AOFFS(nxt, nA0, nA1);
            unsigned x0[2], x1[2];
#pragma unroll
            for (int i = 0; i < 2; ++i) { x0[i] = (GATHER && last) ? nA0[i] : vA0[i]; x1[i] = (GATHER && last) ? nA1[i] : vA1[i]; }
            PG8_LDA(At, 0, 1); PG8_STAGE(PG8_SA(0, 0), a2, x0);
            PG8_BAR; PG8_WAIT_L(0); PG8_MMA(1, 0, At, B0); PG8_BAR; PG8_SCHED;
            PG8_STAGE(PG8_SB(0, 1), b2, voffB1);
            PG8_WAIT_V(6); PG8_BAR; PG8_MMA(1, 1, At, B1); PG8_BAR;
            PG8_LDB(B0, 1, 0); PG8_SCHED; PG8_LDA(At, 1, 0); PG8_STAGE(PG8_SA(0, 1), a2, x1);
            PG8_WAIT_L(8); PG8_BAR; PG8_WAIT_L(0); PG8_MMA(0, 0, At, B0); PG8_BAR; PG8_SCHED;
            PG8_LDB(B1, 1, 1); PG8_STAGE(PG8_SB(1, 0), b3, voffB);
            PG8_BAR; PG8_WAIT_L(0); PG8_MMA(0, 1, At, B1); PG8_BAR;
            PG8_LDA(At, 1, 1); PG8_STAGE(PG8_SA(1, 0), a3, x0);
            PG8_BAR; PG8_WAIT_L(0); PG8_MMA(1, 0, At, B0); PG8_BAR; PG8_SCHED;
            PG8_STAGE(PG8_SB(1, 1), b3, voffB1);
            PG8_WAIT_V(6); PG8_BAR; PG8_MMA(1, 1, At, B1); PG8_BAR;
            if (tabtrip) { if (TAB == 1) *(LAS unsigned*)(tabl + (nxt.tsel * 256 + tid) * 8) = tq.x; else *(LAS u32x2*)(tabl + (nxt.tsel * 256 + tid) * 8) = tq; }
        }
        { int fr_ = fr, fq_ = fq; asm volatile("" : "+v"(fr_), "+v"(fq_));
          E(acc, cur, wr, wc, fr_, fq_); }
        if (!has_next) break;
#pragma unroll
        for (int a = 0; a < 2; ++a)
#pragma unroll
            for (int b = 0; b < 2; ++b)
#pragma unroll
                for (int m = 0; m < 4; ++m)
#pragma unroll
                    for (int n = 0; n < 2; ++n) acc[a][b][m][n] = (f32x4){0.f, 0.f, 0.f, 0.f};
        cur = nxt; cA = nA; cB = nB; ++ui;
        if (GATHER) {
#pragma unroll
            for (int i = 0; i < 2; ++i) { vA0[i] = nA0[i]; vA1[i] = nA1[i]; } }
    }
    PG8_WAIT_V(0);
    if (wr == 0) PG8_BAR;
    PG8_BAR;
#undef PG8_SA
#undef PG8_SB
#undef PG8_STAGE
#undef PG8_LDA
#undef PG8_LDB
#undef PG8_MMA
#undef PG8_WAIT_V
#undef PG8_WAIT_L
#undef PG8_BAR
#undef PG8_SCHED
#undef PG8_AOFFS
}

DEV bool unit_order(int i, int nM, int nN, int& pm, int& pn) {
    const int nwg = nM * nN; const long L = (long)i * gridDim.x + blockIdx.x; if (L >= nwg) return false;
    int wgid = (int)L; { const int q = nwg / 8, r = nwg % 8, xcd = wgid % 8, off = wgid / 8; wgid = (xcd < r ? xcd * (q + 1) : r * (q + 1) + (xcd - r) * q) + off; }
    const int nig = 8 * nN, gid = wgid / nig, fm = gid * 8, gsz = (nM - fm) < 8 ? (nM - fm) : 8;
    pm = fm + ((wgid % nig) % gsz); pn = (wgid % nig) / gsz; return true;
}
struct SchedPlain { const bf16_t* A; long lda; const bf16_t* Bt; long ldb; int nM, nN; long ldo;
    DEV bool next(int i, Unit& u) const { int pm, pn; if (!unit_order(i, nM, nN, pm, pn)) return false;
        u.pm = pm; u.pn = pn; u.e = 0; u.arow = nullptr; u.tab = nullptr; u.A = A + (long)pm * 256 * lda; u.Bt = Bt + (long)pn * 256 * ldb; u.ooff = (long)pm * 256 * ldo + (long)pn * 256; return true; } };
struct SchedF1 { const bf16_t* dft1; const bf16_t* zf;
    DEV bool next(int i, Unit& u) const { const long L = (long)i * gridDim.x + blockIdx.x; if (L >= 256) return false;
        const int b = (int)L >> 6, g = ((int)L >> 4) & 3, which = ((int)L >> 3) & 1, tt = (int)L & 7;
        u.pm = 0; u.pn = 0; u.e = 0; u.arow = nullptr; u.tab = nullptr; u.A = dft1 + which * 65536; u.Bt = zf + ((long)((b * 2 + which) * 2048 + tt * 256) * 1024 + g * 256);
        u.ooff = ((long)(b * 1024 + g * 256) * 4096 + which * 2048 + tt * 256); return true; } };
struct SchedF2 { const bf16_t* dft2; const bf16_t* wtf;
    DEV bool next(int i, Unit& u) const { const long L = (long)i * gridDim.x + blockIdx.x; if (L >= 256) return false;
        const int b = (int)L >> 6, which = ((int)L >> 5) & 1, pm = ((int)L >> 2) & 7, pn = (int)L & 3;
        u.pm = pm; u.pn = pn; u.e = 0; u.arow = nullptr; u.tab = nullptr; u.A = dft2 + ((long)which * 2048 + pm * 256) * 2048; u.Bt = wtf + (long)(b * 1024 + pn * 256) * 4096 + which * 2048;
        u.ooff = ((long)(b * 2 + which) * 2048 + pm * 256) * 1024 + pn * 256; return true; } };
struct SchedMoe1 { const unsigned char* U; const int* row_src; LAS const int* tile_e; const unsigned char* w1l; int ntiles;
    DEV bool next(int i, Unit& u) const { int rt, pn; { const int nwg = ntiles * 4; const long L = (long)i * gridDim.x + blockIdx.x; if (L >= nwg) return false;
        int wgid = (int)L; const int q = nwg / 8, r = nwg % 8, xcd = wgid % 8, off = wgid / 8; wgid = (xcd < r ? xcd * (q + 1) : r * (q + 1) + (xcd - r) * q) + off;
        rt = wgid >> 2; pn = wgid & 3; }
        const int e = tile_e[rt];
        u.pm = rt; u.pn = pn; u.e = e; u.arow = row_src + (long)rt * 256; u.tab = u.arow; u.A = (const bf16_t*)U; u.Bt = (const bf16_t*)(w1l + ((long)e * 1024 + pn * 256) * DM); u.ooff = 0; return true; } };
struct SchedMoe2 { const bf16_t* H; const u32x2* row_rec; LAS const int* tile_e; const bf16_t* w2l; int ntiles;
    DEV bool next(int i, Unit& u) const { int rt, pn; if (!unit_order(i, ntiles, 8, rt, pn)) return false; const int e = tile_e[rt];
        u.pm = rt; u.pn = pn; u.e = e; u.arow = nullptr; u.tab = row_rec + (long)rt * 256; u.A = H + (long)rt * 256 * DEXP; u.Bt = w2l + ((long)e * DM + pn * 256) * DEXP; u.ooff = 0; return true; } };

struct TJob { const float* src; int ld_src, Nn, k0, n0; bf16_t* dst; int ld_dst, kind; float scale; };
constexpr int TJ_WIN = 32 * 18, TJ_SQ = 32 * 8, TJ_QKV = 32 * 24, TJ_EXP = 65 * 3 * 64;
constexpr int TJ_SPLIT = CONV_IN_SCAN ? (TJ_WIN) : (TJ_WIN + 2 * TJ_SQ + TJ_QKV + 2 * TJ_EXP);
DEV void expert_job(const Params& p, int L, int layer, TJob& j) {
    const int e = L / 192, rem = L % 192, kind = rem / 64, tl = rem % 64, mat = layer * 65 + e;
    if (kind < 2) {
        j.src = (e < 64) ? ((kind ? p.exp_up : p.exp_gate) + ((long)(layer * 64 + e) * DM * DEXP)) : ((kind ? p.sh_up : p.sh_gate) + (long)layer * DM * DEXP);
        j.ld_src = DEXP; j.Nn = DEXP; j.k0 = (tl >> 1) * 64; j.n0 = (tl & 1) * 256; j.dst = (bf16_t*)(p.w1 + (long)mat * 1024 * DM); j.ld_dst = DM; j.kind = 1 + kind; j.scale = 32.0f;
    } else {
        j.src = (e < 64) ? (p.exp_down + ((long)(layer * 64 + e) * DEXP * DM)) : (p.sh_down + (long)layer * DEXP * DM);
        j.ld_src = DM; j.Nn = DM; j.k0 = (tl >> 3) * 64; j.n0 = (tl & 7) * 256; j.dst = p.w2 + (long)mat * DM * DEXP; j.ld_dst = DEXP;
    }
}
DEV bool prologue_job(const Params& p, int L, TJob& j) {
    j.scale = 1.0f; j.kind = 0;
    if (L < TJ_WIN) { j.src = p.ab_w_in; j.ld_src = IN_AB; j.Nn = IN_AB; j.k0 = (L / 18) * 64; j.n0 = (L % 18) * 256; j.dst = p.wt_in; j.ld_dst = DM; return true; }
    L -= TJ_WIN;
    if (L < TJ_SQ) { j.src = p.ab_w_out; j.ld_src = DM; j.Nn = DM; j.k0 = (L / 8) * 64; j.n0 = (L % 8) * 256; j.dst = p.wt_out0; j.ld_dst = DM; return true; }
    L -= TJ_SQ;
    if (L < TJ_EXP) { expert_job(p, L, 0, j); return true; }
    L -= TJ_EXP;
    if (L < TJ_QKV) { j.src = p.dsa_w_qkv; j.ld_src = 3 * DM; j.Nn = 3 * DM; j.k0 = (L / 24) * 64; j.n0 = (L % 24) * 256; j.dst = p.wt_qkv; j.ld_dst = DM; j.kind = 3; j.scale = 32.0f; return true; }
    L -= TJ_QKV;
    if (L < TJ_SQ) { j.src = p.dsa_w_out; j.ld_src = DM; j.Nn = DM; j.k0 = (L / 8) * 64; j.n0 = (L % 8) * 256; j.dst = p.wt_o1; j.ld_dst = DM; return true; }
    L -= TJ_SQ;
    if (L < TJ_EXP) { expert_job(p, L, 1, j); return true; }
    return false;
}
DEV void tjob_load(const TJob& j, int tid, f32x4 (&v)[8]) {
    const int kq = tid >> 6, n = j.n0 + 4 * (tid & 63);
#pragma unroll
    for (int i = 0; i < 8; ++i) v[i] = (n < j.Nn) ? *(const f32x4*)(j.src + (long)(j.k0 + kq * 8 + i) * j.ld_src + n) : (f32x4){0.f, 0.f, 0.f, 0.f};
}
DEV void tjob_store(const TJob& j, int tid, const f32x4 (&v)[8], LAS unsigned char* lds) {
    const int kq = tid >> 6, nl = tid & 63;
#pragma unroll
    for (int c = 0; c < 4; ++c) {
        u32x4 w; w.x = cvt_pk_bf16(v[0][c] * j.scale, v[1][c] * j.scale); w.y = cvt_pk_bf16(v[2][c] * j.scale, v[3][c] * j.scale);
        w.z = cvt_pk_bf16(v[4][c] * j.scale, v[5][c] * j.scale); w.w = cvt_pk_bf16(v[6][c] * j.scale, v[7][c] * j.scale);
        *(LAS u32x4*)(lds + (4 * nl + c) * 128 + ((kq ^ (nl & 7)) * 16)) = w;
    }
    __syncthreads();
#pragma unroll
    for (int ps = 0; ps < 4; ++ps) {
        const int nr = ps * 64 + (tid >> 3), slot = tid & 7, n = j.n0 + nr;
        const u32x4 w = *(const LAS u32x4*)(lds + nr * 128 + ((slot ^ ((nr >> 2) & 7)) * 16));
        const long drow = j.kind ? (256 * (n >> 7) + 128 * (j.kind - 1) + (n & 127)) : n;
        if (n < j.Nn) *(u32x4*)(j.dst + drow * j.ld_dst + j.k0 + slot * 8) = w;
    }
    __syncthreads();
}

DEV void phase_prologue(const Params& p, const int WV, LAS unsigned char* lds) {
    const int TIDX = opaque_tid(WV);
    const int G = gridDim.x, tid = TIDX;
    const long gtid = (long)blockIdx.x * NTHREADS + tid, gsz = (long)G * NTHREADS;
    {
        TJob cur, nxt; f32x4 va[8], vb[8];
        int L = blockIdx.x; bool have = L < TJ_SPLIT && prologue_job(p, L, cur);
        if (have) tjob_load(cur, tid, va);
        while (have) {
            const bool hn = L + G < TJ_SPLIT && prologue_job(p, L + G, nxt);
            if (hn) tjob_load(nxt, tid, vb);
            tjob_store(cur, tid, va, lds);
            if (!hn) break;
            L += 2 * G;
            const bool hc = L < TJ_SPLIT && prologue_job(p, L, cur);
            if (hc) tjob_load(cur, tid, va);
            tjob_store(nxt, tid, vb, lds);
            have = hc;
        }
    }
    for (long i = gtid; i < (long)(INP - IN_AB) * DM / 8; i += gsz) *(u32x4*)(p.wt_in + (long)IN_AB * DM + i * 8) = (u32x4){0u, 0u, 0u, 0u};
    for (long i = gtid; i < 256L * DM / 8; i += gsz) *(u32x4*)(p.U + (long)NTOK * DM + i * 8) = (u32x4){0u, 0u, 0u, 0u};
    for (long i = gtid; i < 256L * DM / 16; i += gsz) *(u32x4*)(p.U8 + (long)NTOK * DM + i * 16) = (u32x4){0u, 0u, 0u, 0u};
    for (long i = gtid; i < 128; i += gsz) p.gcnt[i] = 0;
    if (gtid == 0) p.meta[8] = 0;
    for (long i = gtid; i < 4096L * 256; i += gsz) {
        const int n = (int)(i >> 8), k = (int)(i & 255), type = n >> 11, z = (n >> 10) & 1, c = n & 1023;
        const int kb = 128 * type + 64 * z; float v = 0.f;
        if (k >= kb && k < kb + 64) v = (type ? p.ab_a_up : p.ab_w_up)[((long)z * 64 + (k - kb)) * 1024 + c];
        p.wl_wa[i] = f2bf(v);
    }
    for (long i = gtid; i < 1024L * 256; i += gsz) {
        const int n = (int)(i >> 8), k = (int)(i & 255);
        p.wl_g[i] = f2bf(k < 160 ? p.ab_g_up[(long)k * 1024 + n] : 0.f);
    }
    for (long i = gtid; i < 2L * 256 * 256; i += gsz) {
        const int which = (int)(i >> 16), c = (int)((i >> 8) & 255), f = (int)(i & 255), m = (c * f) & 255;
        const float a = (float)m * (1.0f / 128.0f);
        p.dft1[i] = f2bf((which ? sinpif(a) : cospif(a)) * 0.0625f);
    }
    for (long i = gtid; i < 2L * 2048 * 2048 / 8; i += gsz) {
        const int which = (int)(i >> 19), tp = (int)(i >> 8) & 2047, k0 = (int)(i & 255) * 8;
        float o[8];
#pragma unroll
        for (int j = 0; j < 8; ++j) { const int m = (tp * (k0 + j)) & 4095; const float a = (float)m * (1.0f / 2048.0f); o[j] = (which ? sinpif(a) : cospif(a)) * 0.015625f; }
        *(u32x4*)(p.dft2 + i * 8) = pack8(o);
    }
    {
        LAS float* sc = (LAS float*)lds;
        LAS float* red = (LAS float*)(lds + 32768);
        for (int i = tid; i < 4 * DM; i += NTHREADS) sc[i] = siluf_(p.c[i]);
        __syncthreads();
        for (int L = blockIdx.x; L < 4 * 48; L += G) {
            const int m = L / 48, cb = L % 48;
            const float* w = ((m & 1) ? p.ada_ffn_w : p.ada_mix_w) + (long)(m >> 1) * DM * 6144;
            const float* bias = ((m & 1) ? p.ada_ffn_b : p.ada_mix_b) + (long)(m >> 1) * 6144;
            const int kg = tid >> 5, c4 = (tid & 31) * 4;
            f32x4 a0 = {0, 0, 0, 0}, a1 = a0, a2 = a0, a3 = a0;
            for (int k = kg * 128; k < kg * 128 + 128; ++k) {
                const f32x4 wv = *(const f32x4*)(w + (long)k * 6144 + cb * 128 + c4);
                a0 += sc[k] * wv; a1 += sc[DM + k] * wv; a2 += sc[2 * DM + k] * wv; a3 += sc[3 * DM + k] * wv;
            }
            *(LAS f32x4*)(red + (kg * 4 + 0) * 128 + c4) = a0; *(LAS f32x4*)(red + (kg * 4 + 1) * 128 + c4) = a1;
            *(LAS f32x4*)(red + (kg * 4 + 2) * 128 + c4) = a2; *(LAS f32x4*)(red + (kg * 4 + 3) * 128 + c4) = a3;
            __syncthreads();
            { const int b = tid >> 7, col = tid & 127; float s = bias[cb * 128 + col];
#pragma unroll
              for (int g = 0; g < 16; ++g) s += red[(g * 4 + b) * 128 + col];
              p.mod[((long)m * 4 + b) * 6144 + cb * 128 + col] = s; }
            __syncthreads();
        }
    }
}

DEV void phase_modulate(const Params& p, const int WV, const float* xin, int m) {
    const int TIDX = opaque_tid(WV);
    const long gtid = (long)blockIdx.x * NTHREADS + TIDX, gsz = (long)gridDim.x * NTHREADS;
    for (long i = gtid; i < (long)NTOK * DM / 8; i += gsz) {
        const long row = i >> 8; const int col = (int)(i & 255) * 8;
        const float* md = p.mod + ((long)m * 4 + (row >> 12)) * 6144;
        float o[8];
#pragma unroll
        for (int h = 0; h < 2; ++h) {
            const f32x4 xv = *(const f32x4*)(xin + row * DM + col + 4 * h), sh = *(const f32x4*)(md + col + 4 * h), sc = *(const f32x4*)(md + DM + col + 4 * h);
#pragma unroll
            for (int j = 0; j < 4; ++j) o[4 * h + j] = xv[j] * (1.0f + sc[j]) + sh[j];
        }
        *(u32x4*)(p.U + row * DM + col) = pack8(o);
    }
}

template <int ESZ = 2, class Epi>
DEV void phase_gemm_plain(LAS unsigned char* lds, const int wv, const bf16_t* A, long lda, const bf16_t* Bt, long ldb, int M, int N, int K, long ldo, const Epi& E) {
#if GEMM_FAST
    { SchedPlain S{A, lda * ESZ / 2, Bt, ldb * ESZ / 2, M / 256, N / 256, ldo}; gemm_phase_fast<0, ESZ>(lds, wv, lda, ldb, K, S, E); return; }
#endif
    const int nN = N / 256, total = (M / 256) * nN;
    for (int L = blockIdx.x; L < total; L += gridDim.x) {
        Unit u; u.pm = L / nN; u.pn = L % nN; u.e = 0; u.arow = nullptr;
        u.A = A + (long)u.pm * 256 * lda; u.Bt = Bt + (long)u.pn * 256 * ldb; u.ooff = (long)u.pm * 256 * ldo + (long)u.pn * 256;
        gemm_tile_simple(u, lda, ldb, K, E);
    }
}
DEV void phase_fourier1(const Params& p, const int WV, LAS unsigned char* lds) {
    const int wv = WV;
    EpiBf16 E{p.wtf, 4096, 0, 1.0f};
    SchedF1 S{p.dft1, p.zf}; gemm_phase_fast<0, 2>(lds, wv, 256, 1024, 256, S, E);
}
DEV void phase_fourier2(const Params& p, const int WV, LAS unsigned char* lds) {
    const int wv = WV;
    EpiBf16 E{p.pq, 1024, 0, 1.0f};
    SchedF2 S{p.dft2, p.wtf}; gemm_phase_fast<0, 2>(lds, wv, 2048, 4096, 2048, S, E);
}
DEV void phase_fold(const Params& p, const int WV) {
    const int tid = opaque_tid(WV);
    for (long i = (long)blockIdx.x * NTHREADS + tid; i < 4L * 2048 * 128; i += (long)gridDim.x * NTHREADS) {
        const int b = (int)(i >> 18), t = (int)(i >> 7) & 2047, c = (int)(i & 127) * 8;
        float x[8], y[8], e[8], o[8];
        unpack8(*(const u32x4*)(p.proj + ((long)b * 4096 + t) * INP + c), x);
        if (t > 0) unpack8(*(const u32x4*)(p.proj + ((long)b * 4096 + 4096 - t) * INP + c), y);
#pragma unroll
        for (int j = 0; j < 8; ++j) { const float yy = t > 0 ? y[j] : 0.f; e[j] = x[j] + yy; o[j] = t > 0 ? x[j] - yy : 0.f; }
        *(u32x4*)(p.zf + ((long)(b * 2 + 0) * 2048 + t) * 1024 + c) = pack8(e);
        *(u32x4*)(p.zf + ((long)(b * 2 + 1) * 2048 + t) * 1024 + c) = pack8(o);
    }
}
DEV void phase_wn(const Params& p, const int WV) {
    const int tid = opaque_tid(WV), lane = tid & 63;
    for (int it = blockIdx.x * 8 + (tid >> 6); it < 4096; it += gridDim.x * 8) {
        const int b = it >> 10, c = it & 1023, g = c >> 8, cl = c & 255;
        const u32x2 zw = *(const u32x2*)(p.proj + ((long)b * 4096 + 2048) * INP + g * 256 + 4 * lane), dw = *(const u32x2*)(p.dft1 + cl * 256 + 4 * lane);
        float sacc = bflo(zw.x) * bflo(dw.x) + bfhi(zw.x) * bfhi(dw.x) + bflo(zw.y) * bflo(dw.y) + bfhi(zw.y) * bfhi(dw.y);
        sacc = wave_sum(sacc);
        if (lane == 0) p.wn[it] = sacc;
    }
}
DEV void phase_nyquist(const Params& p, const int WV) {
    const int tid = opaque_tid(WV), lane = tid & 63;
    for (int it = blockIdx.x * 8 + (tid >> 6); it < 4096; it += gridDim.x * 8) {
        const int b = it >> 10, c = it & 1023;
        const bf16_t* row = p.wtf + (long)(b * 1024 + c) * 4096;
        float sacc = 0.f;
#pragma unroll
        for (int q = 0; q < 4; ++q) { float f[8]; unpack8(*(const u32x4*)(row + q * 512 + 8 * lane), f);
            sacc += (f[0] - f[1]) + (f[2] - f[3]) + (f[4] - f[5]) + (f[6] - f[7]); }
        sacc = wave_sum(sacc);
        if (lane == 0) p.ycat[((long)b * 4096 + 2048) * DM + c] = f2bf((sacc + p.wn[it]) * 0.015625f);
    }
}
DEV void phase_unfold(const Params& p, const int WV) {
    const int tid = opaque_tid(WV);
    for (long i = (long)blockIdx.x * NTHREADS + tid; i < 4L * 2048 * 128; i += (long)gridDim.x * NTHREADS) {
        const int b = (int)(i >> 18), t = (int)(i >> 7) & 2047, c = (int)(i & 127) * 8;
        float P[8], Q[8], lo[8], hi[8];
        unpack8(*(const u32x4*)(p.pq + ((long)(b * 2 + 0) * 2048 + t) * 1024 + c), P); unpack8(*(const u32x4*)(p.pq + ((long)(b * 2 + 1) * 2048 + t) * 1024 + c), Q);
        const f32x4 w0 = *(const f32x4*)(p.wn + b * 1024 + c), w1 = *(const f32x4*)(p.wn + b * 1024 + c + 4);
        const float sg = (t & 1) ? -0.015625f : 0.015625f;
#pragma unroll
        for (int j = 0; j < 8; ++j) { const float pw = P[j] + sg * (j < 4 ? w0[j & 3] : w1[j & 3]); lo[j] = pw - Q[j]; hi[j] = pw + Q[j]; }
        *(u32x4*)(p.ycat + ((long)b * 4096 + t) * DM + c) = pack8(lo);
        if (t > 0) *(u32x4*)(p.ycat + ((long)b * 4096 + 4096 - t) * DM + c) = pack8(hi);
    }
}
DEV void phase_moe1(const Params& p, const int WV, int layer, LAS unsigned char* lds) {
    const int wv = WV;
    EpiMoe1 E{p.H};
    const int ntiles = p.meta[0], total = ntiles * 4;
#if GEMM_FAST
    { LAS int* te = (LAS int*)(lds + 131072 + 4096);
      for (int i = opaque_tid(wv); i < ntiles; i += NTHREADS) te[i] = p.tile_e[i];
      __syncthreads();
      SchedMoe1 S{p.U8, p.row_src, te, p.w1 + (long)layer * 65 * 1024 * DM, ntiles}; gemm_phase_fast<1, 1>(lds, wv, DM, DM, DM, S, E); return; }
#endif
    (void)total;
}
DEV void phase_moe2(const Params& p, const int WV, int layer, LAS unsigned char* lds, bool skip = false) {
    const int wv = WV;
    EpiMoe2 E{p.slot, (LAS const unsigned char*)(lds + 131072), skip};
    const int ntiles = p.meta[0], total = ntiles * 8;
#if GEMM_FAST
    { LAS int* te = (LAS int*)(lds + 131072 + 4096);
      for (int i = opaque_tid(wv); i < ntiles; i += NTHREADS) te[i] = p.tile_e[i];
      __syncthreads();
      for (int d = 0; d < (int)(blockIdx.x & 3) * MOE2_STAGGER; ++d) __builtin_amdgcn_s_sleep(127);
      SchedMoe2 S{p.H, p.row_rec, te, p.w2 + (long)layer * 65 * DM * DEXP, ntiles}; gemm_phase_fast<2, 2>(lds, wv, DEXP, DEXP, DEXP, S, E); return; }
#endif
    (void)total;
}

DEV float xor_sum8(float v) { v += SHFLX(v, 1); v += SHFLX(v, 2); v += SHFLX(v, 4); return v; }
DEV void phase_rwkv_prep(const Params& p, const int WV) {
    const int tid0 = opaque_tid(WV);
    const int tid = tid0 < 448 ? tid0 : tid0 - 64;
    const int rbeg = tid0 < 448 ? 0 : 32, nrows_sel = tid0 < 384 ? 64 : 32;
    const int col = 8 * tid;
    float mp[8], mn[8];
#pragma unroll
    for (int j = 0; j < 8; ++j) { mp[j] = tid < 436 ? p.ab_mu_prev[col + j] : 0.f; mn[j] = tid < 436 ? p.ab_mu_next[col + j] : 0.f; }
    float kkw[8];
#pragma unroll
    for (int j = 0; j < 8; ++j) kkw[j] = (tid >= 128 && tid < 256) ? p.ab_k_k[col - 1024 + j] : 0.f;
    const int rows_per_block = NTOK / gridDim.x;
    const int myrows = rows_per_block * nrows_sel / 64;
    const long row0 = (long)blockIdx.x * rows_per_block + (long)rows_per_block * rbeg / 64;
    if (tid >= 436) {
        for (int i = 0; i < myrows; ++i) *(u32x4*)(p.alora + (row0 + i) * 512 + 416 + 8 * (tid - 436)) = (u32x4){0u, 0u, 0u, 0u};
        return;
    }
    const bf16_t* pc = p.proj + 1024 + col;
    const long rlast = row0 + myrows;
    auto ldrow = [&](long r) { const long rc = r < rlast ? r : rlast; return *(const u32x4*)(pc + (rc < NTOK ? rc : (long)NTOK - 1) * INP); };
    u32x4 prvq = ldrow(row0 > 0 ? row0 - 1 : 0), curq = ldrow(row0), nq[8];
#pragma unroll
    for (int k = 0; k < 8; ++k) nq[k] = ldrow(row0 + 1 + k);
#pragma unroll 1
    for (int i0 = 0; i0 < myrows; i0 += 8) {
#pragma unroll
        for (int k = 0; k < 8; ++k) {
            const long row = row0 + i0 + k; const int t = (int)(row & 4095);
            const u32x4 nxtq = nq[k];
            nq[k] = ldrow(row + 9);
            float cur[8], prv[8], nxt[8], v[8];
            unpack8(curq, cur); unpack8(prvq, prv); unpack8(nxtq, nxt);
#pragma unroll
            for (int j = 0; j < 8; ++j) { const float pv = t > 0 ? prv[j] : 0.f, nv = t < 4095 ? nxt[j] : 0.f; v[j] = cur[j] + mp[j] * (pv - cur[j]) + mn[j] * (nv - cur[j]); }
            if (tid < 128) *(u32x4*)(p.R + row * 1024 + col) = pack8(v);
            else if (tid < 256) {
                *(u32x4*)(p.K + row * 1024 + col - 1024) = pack8(v);
                float kv[8], ss = 0.f;
#pragma unroll
                for (int j = 0; j < 8; ++j) { kv[j] = v[j] * kkw[j]; ss += kv[j] * kv[j]; }
                ss = xor_sum8(ss);
                const float inv = 1.0f / fmaxf(sqrtf(ss), 1e-12f);
#pragma unroll
                for (int j = 0; j < 8; ++j) kv[j] *= inv;
                *(u32x4*)(p.KK + row * 1024 + col - 1024) = pack8(kv);
            } else if (tid < 384) *(u32x4*)(p.V + row * 1024 + col - 2048) = pack8(v);
            else {
                float o[8];
#pragma unroll
                for (int j = 0; j < 8; ++j) { const float e2 = __expf((tid < 400 ? 2.0f : -1.0f) * fminf(fmaxf(v[j], -15.f), 15.f)), rc = __builtin_amdgcn_rcpf(e2 + 1.0f);
                    o[j] = tid < 400 ? (e2 - 1.0f) * rc : (tid < 416 ? v[j] : rc); }
                *(u32x4*)(p.alora + row * 512 + (col - 3072)) = pack8(o);
            }
            prvq = curq; curq = nxtq;
        }
    }
}

DEV void scan_bar() { asm volatile("s_waitcnt lgkmcnt(0)" ::: "memory"); __builtin_amdgcn_s_barrier(); asm volatile("" ::: "memory"); }
DEV void phase_scan(const Params& p, const int WV, LAS unsigned char* lds, bool nosteps = false) {
    const int tid = opaque_tid(WV);
    LAS float* vec = (LAS float*)lds;
    LAS bf16_t* vbuf = (LAS bf16_t*)(lds + 81920);
    LAS float* ybuf = (LAS float*)(lds + 86016);
    LAS unsigned char* img = lds + 94208;
    const int wid = tid >> 6, lane = tid & 63;
    const int nunits = (256 - (int)blockIdx.x + (int)gridDim.x - 1) / (int)gridDim.x;
    if (wid < 4) {
        const int jg = lane & 15, rg = lane >> 4;
        __builtin_amdgcn_s_setprio(3);
        for (int L = blockIdx.x; L < 256; L += gridDim.x) {
            f32x2 S0l = {0.f, 0.f}, S0h = {0.f, 0.f}, S1l = {0.f, 0.f}, S1h = {0.f, 0.f};
            scan_bar();
#pragma unroll 1
            for (int c = 0; c < 128; ++c) {
                const int buf = c & 1;
                const LAS float* vb = vec + buf * 32 * 320 + 4 * jg;
                const LAS bf16_t* vv = vbuf + buf * 1024 + 8 * wid + 2 * rg;
                LAS float* yb = ybuf + buf * 1024 + 8 * wid + 2 * rg;
                f32x4 b4 = *(const LAS f32x4*)(vb + 64), w4 = *(const LAS f32x4*)(vb + 128), k4 = *(const LAS f32x4*)(vb + 192), r4 = *(const LAS f32x4*)(vb + 256);
                f32x4 an4 = *(const LAS f32x4*)(vb + 320);
                unsigned v2w = *(const LAS unsigned*)(vv);
                f32x4 b41 = *(const LAS f32x4*)(vb + 320 + 64), w41 = *(const LAS f32x4*)(vb + 320 + 128), k41 = *(const LAS f32x4*)(vb + 320 + 192), r41 = *(const LAS f32x4*)(vb + 320 + 256);
                f32x4 an41 = *(const LAS f32x4*)(vb + 640); unsigned v2w1 = *(const LAS unsigned*)(vv + 32);
                float sa0, sa1;
                { const f32x4 a4 = *(const LAS f32x4*)(vb);
                  const f32x2 al = {a4[0], a4[1]}, ah = {a4[2], a4[3]};
                  const f32x2 t0 = S0l * al + S0h * ah, t1 = S1l * al + S1h * ah;
                  sa0 = t0.x + t0.y; sa1 = t1.x + t1.y;
                  dpp_sum16_pair(sa0, sa1); }
#pragma unroll 4
                for (int s = 0; s < (nosteps ? 0 : 32); ++s) {
                    const f32x4 nb = *(const LAS f32x4*)(vb + (s + 2) * 320 + 64), nw = *(const LAS f32x4*)(vb + (s + 2) * 320 + 128),
                                nk = *(const LAS f32x4*)(vb + (s + 2) * 320 + 192), nr = *(const LAS f32x4*)(vb + (s + 2) * 320 + 256), na = *(const LAS f32x4*)(vb + (s + 3) * 320);
                    const unsigned nvw = *(const LAS unsigned*)(vv + (s + 2) * 32);
                    const f32x2 v2 = {bflo(v2w), bfhi(v2w)};
                    const f32x2 bl = {b4[0], b4[1]}, bh = {b4[2], b4[3]}, wl = {w4[0], w4[1]}, wh = {w4[2], w4[3]},
                                kl = {k4[0], k4[1]}, kh = {k4[2], k4[3]}, rl = {r4[0], r4[1]}, rh = {r4[2], r4[3]}, al = {an4[0], an4[1]}, ah = {an4[2], an4[3]};
                    S0l = S0l * wl + bl * sa0 + kl * v2.x; S0h = S0h * wh + bh * sa0 + kh * v2.x;
                    S1l = S1l * wl + bl * sa1 + kl * v2.y; S1h = S1h * wh + bh * sa1 + kh * v2.y;
                    const f32x2 u0 = S0l * rl + S0h * rh, u1 = S1l * rl + S1h * rh, q0 = S0l * al + S0h * ah, q1 = S1l * al + S1h * ah;
                    float y0, y1;
                    dpp_sum16_quad(y0, y1, sa0, sa1, u0, u1, q0, q1);
                    *(LAS f32x2*)(yb + s * 32) = (f32x2){y0, y1};
                    b4 = b41; w4 = w41; k4 = k41; r4 = r41; an4 = an41; v2w = v2w1; b41 = nb; w41 = nw; k41 = nk; r41 = nr; an41 = na; v2w1 = nvw;
                }
                scan_bar();
            }
        }
        __builtin_amdgcn_s_setprio(0);
        scan_bar(); scan_bar(); scan_bar();
    } else {
        int ltv = tid & 255, tc = 0;
        int ub = 0, uh = 0, uz = 0, uhalf = 0;
        float ka[8];
        u32x4 gq[2][6];
        auto gld = [&](u32x4& dst, const unsigned off, const void* ptr) {
            const unsigned long long bi = (unsigned long long)ptr;
            const unsigned lo = (unsigned)__builtin_amdgcn_readfirstlane((int)(unsigned)bi), hi = (unsigned)__builtin_amdgcn_readfirstlane((int)(unsigned)(bi >> 32));
            const unsigned long long bs = ((unsigned long long)hi << 32) | lo;
            asm volatile("s_nop 4\n\tglobal_load_dwordx4 %0, %1, %2" : "=&v"(dst) : "v"(off), "s"(bs) : "memory");
        };
        auto gload = [&](int c, const int R) {
            const int tt = c * 32 + (ltv >> 3), t = uz ? 4095 - tt : tt; const unsigned row = (unsigned)(ub * 4096 + t), col = (unsigned)(uh * 64 + 8 * (ltv & 7));
            const unsigned o1 = (row * 1024u + col) * 2u, o2 = ((row * 2u + (unsigned)uz) * 1024u + col) * 2u, o3 = (row * 1024u + (unsigned)(uh * 64 + 32 * uhalf + 8 * ((ltv & 7) & 3))) * 2u;
            gld(gq[R][0], o1, p.KK); gld(gq[R][1], o1, p.K); gld(gq[R][2], o1, p.R); gld(gq[R][3], o2, p.iclr); gld(gq[R][4], o2, p.omw); gld(gq[R][5], o3, p.V);
        };
        auto gwrite = [&](int buf, const int R) {
#pragma unroll
            for (int i = 0; i < 6; ++i) asm volatile("" : "+v"(gq[R][i]));
            float kk[8], kx[8], rx[8], ic[8], om[8];
            unpack8(gq[R][0], kk); unpack8(gq[R][1], kx); unpack8(gq[R][2], rx); unpack8(gq[R][3], ic); unpack8(gq[R][4], om);
            LAS float* d = vec + ((buf * 32 + (ltv >> 3)) * 5) * 64 + 8 * (ltv & 7);
#pragma unroll
            for (int j = 0; j < 8; ++j) {
                d[j] = -kk[j]; d[64 + j] = kk[j] * ic[j]; d[128 + j] = 1.0f - om[j]; d[192 + j] = kx[j] * (1.0f + (ic[j] - 1.0f) * ka[j]); d[256 + j] = rx[j];
            }
            if ((ltv & 7) < 4) *(LAS u32x4*)(vbuf + (buf * 32 + (ltv >> 3)) * 32 + 8 * (ltv & 7)) = gq[R][5];
        };
        auto flush = [&](int c, int buf) {
            const int tt = c * 32 + (ltv >> 3), t = uz ? 4095 - tt : tt; const long row = (long)ub * 4096 + t;
            const f32x4 yv = *(LAS f32x4*)(ybuf + (buf * 32 + (ltv >> 3)) * 32 + 4 * (ltv & 7));
            *(u32x2*)(p.Y + ((long)uz * NTOK + row) * 1024 + uh * 64 + 32 * uhalf + 4 * (ltv & 7)) = (u32x2){cvt_pk_bf16(yv[0], yv[1]), cvt_pk_bf16(yv[2], yv[3])};
        };
        f32x4 tv[2][16];
        auto tjob = [&](int jc, TJob& j) { int Lj = TJ_SPLIT + (int)blockIdx.x + (int)gridDim.x * (jc < 0 ? 0 : jc); const int last = TJ_WIN + 2 * TJ_SQ + TJ_QKV + 2 * TJ_EXP - 1;
            if (Lj > last) Lj = last; return prologue_job(p, Lj, j); };
        auto tload = [&](int jc, const int R) {
            TJob tj;
            if (tjob(jc, tj)) {
                const char* base = (const char*)(tj.src + (long)tj.k0 * tj.ld_src + tj.n0);
                const unsigned voff = (unsigned)(((ltv >> 6) * 16 * tj.ld_src + 4 * (ltv & 63)) * 4);
                const unsigned long long b0 = (unsigned long long)base, st = (unsigned long long)tj.ld_src * 4ull;
#pragma unroll
                for (int i = 0; i < 16; ++i) { const unsigned long long bi = b0 + st * (unsigned)i;
                    const unsigned lo = (unsigned)__builtin_amdgcn_readfirstlane((int)(unsigned)bi), hi = (unsigned)__builtin_amdgcn_readfirstlane((int)(unsigned)(bi >> 32));
                    const unsigned long long bs = ((unsigned long long)hi << 32) | lo;
                    asm volatile("s_nop 4\n\tglobal_load_dwordx4 %0, %1, %2" : "=&v"(tv[R][i]) : "v"(voff), "s"(bs) : "memory"); } }
        };
        auto twrite = [&](int jc, const int ib, bool steady = false) {
            TJob tj;
            if (tjob(jc, tj)) { const int kq = ltv >> 6, nl = ltv & 63;
                if (steady && jc >= 3) asm volatile("s_waitcnt vmcnt(38)" ::: "memory"); else asm volatile("s_waitcnt vmcnt(0)" ::: "memory");
#pragma unroll
                for (int i = 0; i < 16; ++i) asm volatile("" : "+v"(tv[ib][i]));
                if (tj.kind) {
#pragma unroll
                    for (int cc = 0; cc < 4; ++cc) {
                        u32x4 w;
#pragma unroll
                        for (int q = 0; q < 4; ++q) w[q] = pack4_fp8(tv[ib][4 * q][cc] * tj.scale, tv[ib][4 * q + 1][cc] * tj.scale, tv[ib][4 * q + 2][cc] * tj.scale, tv[ib][4 * q + 3][cc] * tj.scale);
                        *(LAS u32x4*)(img + ib * 32768 + (4 * nl + cc) * 64 + ((kq ^ (nl & 3)) * 16)) = w;
                    }
                } else
#pragma unroll
                for (int cc = 0; cc < 4; ++cc)
#pragma unroll
                    for (int hh = 0; hh < 2; ++hh) {
                        u32x4 w; w.x = cvt_pk_bf16(tv[ib][8 * hh][cc], tv[ib][8 * hh + 1][cc]); w.y = cvt_pk_bf16(tv[ib][8 * hh + 2][cc], tv[ib][8 * hh + 3][cc]);
                        w.z = cvt_pk_bf16(tv[ib][8 * hh + 4][cc], tv[ib][8 * hh + 5][cc]); w.w = cvt_pk_bf16(tv[ib][8 * hh + 6][cc], tv[ib][8 * hh + 7][cc]);
                        *(LAS u32x4*)(img + ib * 32768 + (4 * nl + cc) * 128 + (((2 * kq + hh) ^ (nl & 7)) * 16)) = w;
                    } }
        };
        auto tstore = [&](int jc, const int ib) {
            TJob j;
            if (tjob(jc, j) && j.kind) {
                const int sh = __builtin_ctz((unsigned)j.ld_dst);
                const unsigned voff = (unsigned)(((ltv >> 2) << sh) + (ltv & 3) * 16);
                const long urow = j.kind == 3 ? (long)j.n0 : (long)(256 * (j.n0 >> 7) + 128 * (j.kind - 1));
                const unsigned char* base = (const unsigned char*)j.dst + (urow << sh) + j.k0;
#pragma unroll
                for (int ps = 0; ps < 4; ++ps) {
                    const int nr = ps * 64 + (ltv >> 2), slot = ltv & 3;
                    const u32x4 w = *(const LAS u32x4*)(img + ib * 32768 + nr * 64 + ((slot ^ ((nr >> 2) & 3)) * 16));
                    const long prow = j.kind == 3 ? (long)(ps * 64) : (long)(256 * (ps >> 1) + 64 * (ps & 1));
                    *(u32x4*)((unsigned char*)base + (prow << sh) + voff) = w;
                }
            } else if (tjob(jc, j)) {
                const int sh = __builtin_ctz((unsigned)j.ld_dst) + 1;
                const unsigned voff = (unsigned)(((ltv >> 3) << sh) + (ltv & 7) * 16);
                const unsigned char* base = (const unsigned char*)j.dst + ((long)j.n0 << sh) + j.k0 * 2;
#pragma unroll
                for (int ps = 0; ps < 8; ++ps) {
                    const int nr = ps * 32 + (ltv >> 3), slot = ltv & 7;
                    const u32x4 w = *(const LAS u32x4*)(img + ib * 32768 + nr * 128 + ((slot ^ ((nr >> 2) & 7)) * 16));
                    *(u32x4*)((unsigned char*)base + ((long)(ps * 32) << sh) + voff) = w;
                } }
        };
        auto lbody = [&](const int c, const int IB) {
            asm volatile("" : "+v"(ltv));
            twrite(tc, IB, true);
            __builtin_amdgcn_sched_barrier(0);
            tload(tc + 2, IB);
            __builtin_amdgcn_sched_barrier(0);
            tstore(tc - 1, IB ^ 1);
            __builtin_amdgcn_sched_barrier(0);
            if (c >= 2) asm volatile("s_waitcnt vmcnt(48)" ::: "memory"); else asm volatile("s_waitcnt vmcnt(0)" ::: "memory");
            gwrite(IB ^ 1, IB ^ 1);
            __builtin_amdgcn_sched_barrier(0);
            gload(c + 3 < 128 ? c + 3 : 127, IB ^ 1);
            flush(c > 0 ? c - 1 : 0, IB ^ 1);
            ++tc;
            scan_bar();
        };
        tload(0, 0); tload(1, 1);
        for (int u = 0; u < nunits; ++u) {
            const int bi = (int)blockIdx.x + u * (int)gridDim.x;
            const int L = (gridDim.x == 256) ? 2 * ((bi & 7) + 8 * (bi >> 4)) + ((bi >> 3) & 1) : bi;
            ub = L >> 6; uh = (L >> 2) & 15; uz = (L >> 1) & 1; uhalf = L & 1;
#pragma unroll
            for (int j = 0; j < 8; ++j) ka[j] = p.ab_k_a[uh * 64 + 8 * (ltv & 7) + j];
            gload(0, 0); asm volatile("s_waitcnt vmcnt(0)" ::: "memory"); gwrite(0, 0); gload(1, 1); gload(2, 0);
            scan_bar();
#pragma unroll 1
            for (int c = 0; c < 128; c += 2) { lbody(c, 0); lbody(c + 1, 1); }
            flush(127, 1);
        }
        tstore(tc - 1, 1); scan_bar();
        twrite(tc, 0); scan_bar();
        tstore(tc, 0); twrite(tc + 1, 1); scan_bar();
        tstore(tc + 1, 1);
    }
    __syncthreads();
}

DEV void phase_postscan(const Params& p, const int WV) {
    const int tid = opaque_tid(WV);
    const int c = 8 * (tid & 127);
    float lg[8], lb[8], ka[8], rk[8];
#pragma unroll
    for (int j = 0; j < 8; ++j) { lg[j] = p.ab_lnx_g[c + j]; lb[j] = p.ab_lnx_b[c + j]; ka[j] = p.ab_k_a[c + j]; rk[j] = p.ab_r_k[c + j]; }
#pragma unroll 2
    for (long row = (long)blockIdx.x * 4 + (tid >> 7); row < NTOK; row += (long)gridDim.x * 4) {
        float y[8], r[8], k[8], v[8], i0[8], i1[8], g[8];
        { float ya[8], yb[8]; unpack8(*(const u32x4*)(p.Y + row * 1024 + c), ya); unpack8(*(const u32x4*)(p.Y + ((long)NTOK + row) * 1024 + c), yb);
#pragma unroll
          for (int j = 0; j < 8; ++j) y[j] = ya[j] + yb[j]; }
        unpack8(*(const u32x4*)(p.R + row * 1024 + c), r); unpack8(*(const u32x4*)(p.K + row * 1024 + c), k); unpack8(*(const u32x4*)(p.V + row * 1024 + c), v);
        unpack8(*(const u32x4*)(p.iclr + (row * 2) * 1024 + c), i0); unpack8(*(const u32x4*)(p.iclr + (row * 2 + 1) * 1024 + c), i1); unpack8(*(const u32x4*)(p.G + row * 1024 + c), g);
        float s = 0.f, dot = 0.f;
#pragma unroll
        for (int j = 0; j < 8; ++j) { s += y[j]; dot += r[j] * k[j] * (2.0f + (i0[j] + i1[j] - 2.0f) * ka[j]) * rk[j]; }
        const float mu = xor_sum8(s) * (1.0f / 64.0f); dot = xor_sum8(dot);
        float q = 0.f;
#pragma unroll
        for (int j = 0; j < 8; ++j) { y[j] -= mu; q += y[j] * y[j]; }
        const float rstd = rsqrtf(xor_sum8(q) * (1.0f / 64.0f) + 6.4e-4f);
        float o[8];
#pragma unroll
        for (int j = 0; j < 8; ++j) o[j] = (y[j] * rstd * lg[j] + lb[j] + dot * v[j]) * g[j];
        *(u32x4*)(p.ycat + row * DM + 1024 + c) = pack8(o);
    }
}

template <int NJ, int W>
DEV void ln_row(float (&v)[NJ][W], const float* g, const float* b, int lane) {
    float s = 0.f;
#pragma unroll
    for (int j = 0; j < NJ; ++j)
#pragma unroll
        for (int i = 0; i < W; ++i) s += v[j][i];
    const float mean = wave_sum(s) * (1.0f / DM);
    float q = 0.f;
#pragma unroll
    for (int j = 0; j < NJ; ++j)
#pragma unroll
        for (int i = 0; i < W; ++i) { const float d = v[j][i] - mean; q += d * d; }
    const float rstd = rsqrtf(wave_sum(q) * (1.0f / DM) + 1e-5f);
#pragma unroll
    for (int j = 0; j < NJ; ++j) {
        const int col = W * (lane + 64 * j);
#pragma unroll
        for (int i4 = 0; i4 < W; i4 += 4) {
            const f32x4 g0 = *(const f32x4*)(g + col + i4), b0 = *(const f32x4*)(b + col + i4);
#pragma unroll
            for (int i = 0; i < 4; ++i) v[j][i4 + i] = (v[j][i4 + i] - mean) * rstd * g0[i] + b0[i];
        }
        asm volatile("" ::: "memory");
    }
}

DEV void phase_lnr(const Params& p, const int WV, int layer, const float* xin, LAS unsigned char* lds, bool dry = false) {
    const int TIDX = opaque_tid(WV);
    LAS float* tile = (LAS float*)lds;
    LAS float* part = (LAS float*)lds;
    LAS int* lcnt = (LAS int*)(lds + 16 * 2052 * 4);
    const int tid = TIDX, wid = tid >> 6, lane = tid & 63, fr = lane & 15, fq = lane >> 4;
    const float* lng = p.ln_mix_g + layer * DM; const float* lnb = p.ln_mix_b + layer * DM;
    const float* rw = p.router_w + (long)layer * DM * NEXP; const float* rb = p.router_b + layer * NEXP;
    const int m = 2 * layer + 1;
    if (tid < 64) lcnt[tid] = 0;
    __syncthreads();
    for (int grp = blockIdx.x; grp < NTOK / 16; grp += gridDim.x) {
        f32x4 xq[2][8]; u32x4 xb[2][4], tq[2][4];
#pragma unroll
        for (int rr = 0; rr < 2; ++rr) {
            const long row = (long)grp * 16 + 2 * wid + rr;
#pragma unroll
            for (int j = 0; j < 4; ++j) {
                const int col = 8 * (lane + 64 * j);
                if (layer == 0) { xq[rr][2 * j] = *(const f32x4*)(xin + row * DM + col); xq[rr][2 * j + 1] = *(const f32x4*)(xin + row * DM + col + 4); }
                else xb[rr][j] = *(const u32x4*)(p.X + row * DM + col);
                tq[rr][j] = *(const u32x4*)(p.T + row * DM + col);
            }
        }
#pragma unroll
        for (int rr = 0; rr < 2; ++rr) {
            const int rl = 2 * wid + rr; const long row = (long)grp * 16 + rl;
            float v[4][8];
#pragma unroll
            for (int j = 0; j < 4; ++j) {
                float xx[8];
                if (layer == 0) {
#pragma unroll
                    for (int i = 0; i < 4; ++i) { xx[i] = xq[rr][2 * j][i]; xx[4 + i] = xq[rr][2 * j + 1][i]; } }
                else unpack8(xb[rr][j], xx);
                float tt[8]; unpack8(tq[rr][j], tt);
#pragma unroll
                for (int i = 0; i < 8; ++i) v[j][i] = ALPHA * xx[i] + tt[i];
            }
            ln_row(v, lng, lnb, lane);
            const float* md = p.mod + ((long)m * 4 + (row >> 12)) * 6144;
#pragma unroll
            for (int j = 0; j < 4; ++j) {
                const int col = 8 * (lane + 64 * j);
                if (dry) { *(f32x4*)(p.out + row * DM + col) = (f32x4){v[j][0], v[j][1], v[j][2], v[j][3]}; *(f32x4*)(p.out + row * DM + col + 4) = (f32x4){v[j][4], v[j][5], v[j][6], v[j][7]}; }
                else *(u32x4*)(p.X + row * DM + col) = pack8(v[j]);
                float uu[8];
#pragma unroll
                for (int hh = 0; hh < 2; ++hh) {
                    const f32x4 sh = *(const f32x4*)(md + col + 4 * hh), sc = *(const f32x4*)(md + DM + col + 4 * hh);
#pragma unroll
                    for (int i = 0; i < 4; ++i) uu[4 * hh + i] = v[j][4 * hh + i] * (1.0f + sc[i]) + sh[i];
                }
                if (!dry) *(u32x2*)(p.U8 + row * DM + col) = (u32x2){pack4_fp8(uu[0], uu[1], uu[2], uu[3]), pack4_fp8(uu[4], uu[5], uu[6], uu[7])};
                *(LAS f32x4*)(tile + rl * 2052 + col) = (f32x4){uu[0], uu[1], uu[2], uu[3]};
                *(LAS f32x4*)(tile + rl * 2052 + col + 4) = (f32x4){uu[4], uu[5], uu[6], uu[7]};
            }
        }
        __syncthreads();
        f32x4 acc[4];
#pragma unroll
        for (int nt = 0; nt < 4; ++nt) acc[nt] = (f32x4){0.f, 0.f, 0.f, 0.f};
        float bwa[32], bwb[32];
        unsigned rvoff = (unsigned)(((256 * wid + 4 * fq) * NEXP + fr) * 4); asm volatile("" : "+v"(rvoff));
#define LNR_LD(dst, blk) do { _Pragma("unroll") for (int jj = 0; jj < 2; ++jj) { const char* rwj = (const char*)rw + (size_t)(16 * (2 * (blk) + jj)) * NEXP * 4; \
            _Pragma("unroll") for (int i = 0; i < 4; ++i) _Pragma("unroll") for (int nt = 0; nt < 4; ++nt) dst[16 * jj + 4 * i + nt] = *(const float*)(rwj + rvoff + (i * NEXP + 16 * nt) * 4); } } while (0)
#define LNR_MM(src, blk) do { _Pragma("unroll") for (int jj = 0; jj < 2; ++jj) { const f32x4 a4 = *(const LAS f32x4*)(tile + fr * 2052 + 256 * wid + 16 * (2 * (blk) + jj) + 4 * fq); \
            _Pragma("unroll") for (int i = 0; i < 4; ++i) _Pragma("unroll") for (int nt = 0; nt < 4; ++nt) acc[nt] = __builtin_amdgcn_mfma_f32_16x16x4f32(a4[i], src[16 * jj + 4 * i + nt], acc[nt], 0, 0, 0); } } while (0)
        LNR_LD(bwa, 0); __builtin_amdgcn_sched_barrier(0);
        LNR_LD(bwb, 1); LNR_MM(bwa, 0); __builtin_amdgcn_sched_barrier(0);
        LNR_LD(bwa, 2); LNR_MM(bwb, 1); __builtin_amdgcn_sched_barrier(0);
        LNR_LD(bwb, 3); LNR_MM(bwa, 2); __builtin_amdgcn_sched_barrier(0);
        LNR_LD(bwa, 4); LNR_MM(bwb, 3); __builtin_amdgcn_sched_barrier(0);
        LNR_LD(bwb, 5); LNR_MM(bwa, 4); __builtin_amdgcn_sched_barrier(0);
        LNR_LD(bwa, 6); LNR_MM(bwb, 5); __builtin_amdgcn_sched_barrier(0);
        LNR_LD(bwb, 7); LNR_MM(bwa, 6); __builtin_amdgcn_sched_barrier(0);
        LNR_MM(bwb, 7);
#undef LNR_LD
#undef LNR_MM
        __syncthreads();
#pragma unroll
        for (int nt = 0; nt < 4; ++nt)
#pragma unroll
            for (int r = 0; r < 4; ++r) part[(wid * 16 + 4 * fq + r) * 64 + 16 * nt + fr] = acc[nt][r];
        __syncthreads();
#pragma unroll 1
        for (int rr = 0; rr < 2; ++rr) {
            const int rl = 2 * wid + rr; const long tok = (long)grp * 16 + rl;
            float logit = 0.f;
#pragma unroll
            for (int w = 0; w < 8; ++w) logit += part[(w * 16 + rl) * 64 + lane];
            const float score = sigmoidf_(logit), biased = score + rb[lane];
            float m1 = biased; m1 = fmaxf(m1, SHFLX(m1, 1)); m1 = fmaxf(m1, SHFLX(m1, 2)); m1 = fmaxf(m1, SHFLX(m1, 4));
            const unsigned long long bal = __ballot(biased == m1);
            const int grp8 = lane >> 3; const unsigned gm = (unsigned)(bal >> (8 * grp8)) & 0xffu;
            const int first = 8 * grp8 + __builtin_ctz(gm);
            float v2 = (lane == first) ? -INFINITY : biased; v2 = fmaxf(v2, SHFLX(v2, 1)); v2 = fmaxf(v2, SHFLX(v2, 2)); v2 = fmaxf(v2, SHFLX(v2, 4));
            const float gs = m1 + v2;
            int grank = 0;
#pragma unroll
            for (int g2 = 0; g2 < 8; ++g2) { const float o = __int_as_float(__builtin_amdgcn_readlane(__float_as_int(gs), g2 * 8)); grank += (o > gs || (o == gs && g2 < grp8)) ? 1 : 0; }
            const float val = (grank < 4) ? biased : -INFINITY;
            int rank = 0;
#pragma unroll
            for (int e2 = 0; e2 < 64; ++e2) { const float o = __int_as_float(__builtin_amdgcn_readlane(__float_as_int(val), e2)); rank += (o > val || (o == val && e2 < lane)) ? 1 : 0; }
            const bool sel = (grank < 4) && (rank < 8);
            const float wsum = wave_sum(sel ? score : 0.f);
            if (sel && !dry) {
                const int pos = __hip_atomic_fetch_add((int*)(lcnt + lane), 1, __ATOMIC_RELAXED, __HIP_MEMORY_SCOPE_WORKGROUP);
                p.sel_e[tok * 8 + rank] = lane; p.sel_pos[tok * 8 + rank] = pos; p.sel_w[tok * 8 + rank] = score / wsum * 2.5f;
            }
        }
        __syncthreads();
    }
    if (tid < 64 && !dry) { const int base = atomicAdd(p.gcnt + layer * 64 + tid, lcnt[tid]); p.blockbase[blockIdx.x * 64 + tid] = base; }
}

DEV void phase_place(const Params& p, const int WV, int layer, LAS unsigned char* lds) {
    const int TIDX = opaque_tid(WV);
    LAS int* pstart = (LAS int*)lds;
    LAS int* cnts = (LAS int*)(lds + 512);
    const int tid = TIDX;
    if (tid < 64) cnts[tid] = p.gcnt[layer * 64 + tid];
    __syncthreads();
    if (tid == 0) { int s = 0; for (int e = 0; e < 64; ++e) { pstart[e] = s; s += (cnts[e] + 255) / 256 * 256; } pstart[64] = s; }
    __syncthreads();
    const int sh0 = pstart[64];
    if (blockIdx.x == 0) {
        if (tid == 0) { p.meta[0] = sh0 / 256 + 64; p.meta[1] = sh0; }
        for (int t = tid; t < sh0 / 256 + 64; t += NTHREADS) {
            int e = 64; const int r0 = t * 256;
            if (r0 < sh0) { e = 0; while (e < 63 && pstart[e + 1] <= r0) ++e; }
            p.tile_e[t] = e;
        }
    }
    for (int e = blockIdx.x; e < 64; e += gridDim.x) {
        const int beg = pstart[e] + cnts[e], end = pstart[e + 1];
        for (int r = beg + tid; r < end; r += NTHREADS) { p.row_src[r] = NTOK; p.row_dst[r] = NTOK * 9; p.row_g[r] = 0.f; p.row_rec[r] = (u32x2){(unsigned)(NTOK * 9), 0u}; }
    }
    for (int grp = blockIdx.x; grp < NTOK / 16; grp += gridDim.x) {
        if (tid < 128) {
            const int tok = grp * 16 + (tid >> 3), s = tid & 7;
            const int e = p.sel_e[tok * 8 + s], dest = pstart[e] + p.blockbase[blockIdx.x * 64 + e] + p.sel_pos[tok * 8 + s];
            const float gw = p.sel_w[tok * 8 + s]; p.row_src[dest] = tok; p.row_dst[dest] = tok * 9 + s; p.row_g[dest] = gw; p.row_rec[dest] = (u32x2){(unsigned)(tok * 9 + s), __float_as_uint(gw)};
        } else if (tid < 144) {
            const int tok = grp * 16 + (tid - 128);
            p.row_src[sh0 + tok] = tok; p.row_dst[sh0 + tok] = tok * 9 + 8; p.row_g[sh0 + tok] = 1.0f; p.row_rec[sh0 + tok] = (u32x2){(unsigned)(tok * 9 + 8), __float_as_uint(1.0f)};
        }
    }
}

DEV void phase_combine(const Params& p, const int WV, int layer, bool dry = false) {
    const int TIDX = opaque_tid(WV);
    const int lane = TIDX & 63; const long gw = (long)blockIdx.x * 8 + __builtin_amdgcn_readfirstlane(TIDX >> 6), nw = (long)gridDim.x * 8;
    const float* lng = p.ln_ffn_g + layer * DM; const float* lnb = p.ln_ffn_b + layer * DM;
    const int m = 2 * layer + 1;
    const int lane0 = lane;
    for (long row = gw; row < NTOK; row += nw) {
        int lane = lane0; asm volatile("" : "+v"(lane));
        const float* md = p.mod + ((long)m * 4 + (row >> 12)) * 6144;
        float v[2][16];
#pragma unroll
        for (int j = 0; j < 2; ++j) {
            const int col = 16 * (lane + 64 * j);
            float h[16];
#pragma unroll
            for (int i = 0; i < 16; ++i) h[i] = 0.f;
#pragma unroll
            for (int s = 0; s < 9; ++s) {
                const u32x4 w = *(const u32x4*)(p.slot + (row * 9 + s) * DM + col);
#pragma unroll
                for (int q = 0; q < 4; ++q) { const f32x2 lo = __builtin_amdgcn_cvt_pk_f32_fp8((int)w[q], false), hi = __builtin_amdgcn_cvt_pk_f32_fp8((int)w[q], true);
                    h[4 * q] += lo.x; h[4 * q + 1] += lo.y; h[4 * q + 2] += hi.x; h[4 * q + 3] += hi.y; }
            }
            if (DBG_ZERO & (layer ? 8 : 2)) {
#pragma unroll
                for (int i = 0; i < 16; ++i) h[i] = 0.f; }
#pragma unroll
            for (int i4 = 0; i4 < 16; i4 += 4) {
                const u32x2 xw = *(const u32x2*)(p.X + row * DM + col + i4); const f32x4 x0 = {bflo(xw.x), bfhi(xw.x), bflo(xw.y), bfhi(xw.y)}, g0 = *(const f32x4*)(md + 2 * DM + col + i4);
#pragma unroll
                for (int i = 0; i < 4; ++i) v[j][i4 + i] = ALPHA * x0[i] + (1.0f + g0[i]) * (h[i4 + i] * 0.015625f);
            }
            asm volatile("" : "+v"(v[j][0]), "+v"(v[j][1]), "+v"(v[j][2]), "+v"(v[j][3]), "+v"(v[j][4]), "+v"(v[j][5]), "+v"(v[j][6]), "+v"(v[j][7]),
                              "+v"(v[j][8]), "+v"(v[j][9]), "+v"(v[j][10]), "+v"(v[j][11]), "+v"(v[j][12]), "+v"(v[j][13]), "+v"(v[j][14]), "+v"(v[j][15]) :: "memory");
        }
        ln_row<2, 16>(v, lng, lnb, lane);
        const bool xbf = !dry && layer == 0;
        const float* md2 = p.mod + ((long)(2 * layer + 2) * 4 + (row >> 12)) * 6144;
#pragma unroll
        for (int j = 0; j < 2; ++j) {
            const int col = 16 * (lane + 64 * j);
#pragma unroll
            for (int i4 = 0; i4 < 16; i4 += 4) {
                if (xbf) *(u32x2*)(p.X + row * DM + col + i4) = (u32x2){cvt_pk_bf16(v[j][i4], v[j][i4 + 1]), cvt_pk_bf16(v[j][i4 + 2], v[j][i4 + 3])};
                else *(f32x4*)(p.out + row * DM + col + i4) = (f32x4){v[j][i4], v[j][i4 + 1], v[j][i4 + 2], v[j][i4 + 3]}; }
            if (layer == 0 && !dry) {
                u32x4 w8;
#pragma unroll
                for (int q4 = 0; q4 < 4; ++q4) {
                    const f32x4 sh = *(const f32x4*)(md2 + col + 4 * q4), sc = *(const f32x4*)(md2 + DM + col + 4 * q4);
                    w8[q4] = pack4_fp8(v[j][4 * q4] * (1.0f + sc[0]) + sh[0], v[j][4 * q4 + 1] * (1.0f + sc[1]) + sh[1], v[j][4 * q4 + 2] * (1.0f + sc[2]) + sh[2], v[j][4 * q4 + 3] * (1.0f + sc[3]) + sh[3]);
                }
                *(u32x4*)(p.U8 + row * DM + col) = w8;
            }
            asm volatile("" ::: "memory");
        }
    }
}

DEV void phase_combine_l1(const Params& p, const int WV, int layer, bool dry = false) {
    const int TIDX = opaque_tid(WV);
    const int lane = TIDX & 63; const long gw = (long)blockIdx.x * 8 + __builtin_amdgcn_readfirstlane(TIDX >> 6), nw = (long)gridDim.x * 8;
    const float* lng = p.ln_ffn_g + layer * DM; const float* lnb = p.ln_ffn_b + layer * DM;
    const int m = 2 * layer + 1;
    const int lane0 = lane;
    for (long row = gw; row < NTOK; row += nw) {
        int lane = opaque_lane();
        const float* md = p.mod + ((long)m * 4 + (row >> 12)) * 6144;
        u32x4 sq[2][9]; u32x2 xq[2][4]; f32x4 gq[2][4], lgq[2][4], lbq[2][4];
#pragma unroll
        for (int j = 0; j < 2; ++j) {
            const int col = 16 * (lane + 64 * j);
#pragma unroll
            for (int s = 0; s < 9; ++s) sq[j][s] = *(const u32x4*)(p.slot + (row * 9 + s) * DM + col);
        }
        float v[2][16];
        float ssum = 0.f;
#pragma unroll
        for (int j = 0; j < 2; ++j) {
#pragma unroll
            for (int i = 0; i < 16; ++i) v[j][i] = 0.f;
#pragma unroll
            for (int s = 0; s < 9; ++s) {
                const u32x4 w = sq[j][s];
#pragma unroll
                for (int q = 0; q < 4; ++q) { const f32x2 lo = __builtin_amdgcn_cvt_pk_f32_fp8((int)w[q], false), hi = __builtin_amdgcn_cvt_pk_f32_fp8((int)w[q], true);
                    v[j][4 * q] += lo.x; v[j][4 * q + 1] += lo.y; v[j][4 * q + 2] += hi.x; v[j][4 * q + 3] += hi.y; }
                if (s % 3 == 2) __builtin_amdgcn_sched_barrier(0);
            }
            if (DBG_ZERO & (layer ? 8 : 2)) {
#pragma unroll
                for (int i = 0; i < 16; ++i) v[j][i] = 0.f; }
            if (j == 0 && layer == 1) {
                __builtin_amdgcn_sched_barrier(0);
                asm volatile("" : "+v"(lane));
#pragma unroll
                for (int jj = 0; jj < 2; ++jj)
#pragma unroll
                    for (int q = 0; q < 4; ++q) { xq[jj][q] = *(const u32x2*)(p.X + row * DM + 16 * (lane + 64 * jj) + 4 * q); gq[jj][q] = *(const f32x4*)(md + 2 * DM + 16 * (lane + 64 * jj) + 4 * q); }
                __builtin_amdgcn_sched_barrier(0);
            }
        }
        if (layer == 0) {
            __builtin_amdgcn_sched_barrier(0);
            asm volatile("" : "+v"(lane));
#pragma unroll
            for (int jj = 0; jj < 2; ++jj)
#pragma unroll
                for (int q = 0; q < 4; ++q) { xq[jj][q] = *(const u32x2*)(p.X + row * DM + 16 * (lane + 64 * jj) + 4 * q); gq[jj][q] = *(const f32x4*)(md + 2 * DM + 16 * (lane + 64 * jj) + 4 * q); }
            __builtin_amdgcn_sched_barrier(0);
        }
#pragma unroll
        for (int j = 0; j < 2; ++j)
#pragma unroll
            for (int q = 0; q < 4; ++q) {
                const u32x2 xw = xq[j][q]; const f32x4 x0 = {bflo(xw.x), bfhi(xw.x), bflo(xw.y), bfhi(xw.y)}, g0 = gq[j][q];
#pragma unroll
                for (int i = 0; i < 4; ++i) { v[j][4 * q + i] = ALPHA * x0[i] + (1.0f + g0[i]) * (v[j][4 * q + i] * 0.015625f); ssum += v[j][4 * q + i]; }
            }
        __builtin_amdgcn_sched_barrier(0);
        asm volatile("" : "+v"(lane));
#pragma unroll
        for (int j = 0; j < 2; ++j)
#pragma unroll
            for (int q = 0; q < 4; ++q) { const int col = 16 * (lane + 64 * j); lgq[j][q] = *(const f32x4*)(lng + col + 4 * q); lbq[j][q] = *(const f32x4*)(lnb + col + 4 * q); }
        __builtin_amdgcn_sched_barrier(0);
        const float mean = wave_sum(ssum) * (1.0f / DM);
        float qsum = 0.f;
#pragma unroll
        for (int j = 0; j < 2; ++j)
#pragma unroll
            for (int i = 0; i < 16; ++i) { const float d = v[j][i] - mean; qsum += d * d; }
        const float rstd = rsqrtf(wave_sum(qsum) * (1.0f / DM) + 1e-5f);
#pragma unroll
        for (int j = 0; j < 2; ++j)
#pragma unroll
            for (int q = 0; q < 4; ++q)
#pragma unroll
                for (int i = 0; i < 4; ++i) v[j][4 * q + i] = (v[j][4 * q + i] - mean) * rstd * lgq[j][q][i] + lbq[j][q][i];
        __builtin_amdgcn_sched_barrier(0);
        asm volatile("" : "+v"(lane));
        const bool xbf = !dry && layer == 0;
        const float* md2 = p.mod + ((long)(2 * layer + 2) * 4 + (row >> 12)) * 6144;
#pragma unroll
        for (int j = 0; j < 2; ++j) {
            const int col = 16 * (lane + 64 * j);
#pragma unroll
            for (int i4 = 0; i4 < 16; i4 += 4) {
                if (xbf) *(u32x2*)(p.X + row * DM + col + i4) = (u32x2){cvt_pk_bf16(v[j][i4], v[j][i4 + 1]), cvt_pk_bf16(v[j][i4 + 2], v[j][i4 + 3])};
                else *(f32x4*)(p.out + row * DM + col + i4) = (f32x4){v[j][i4], v[j][i4 + 1], v[j][i4 + 2], v[j][i4 + 3]}; }
            if (layer == 0 && !dry) {
                u32x4 w8;
#pragma unroll
                for (int q4 = 0; q4 < 4; ++q4) {
                    const f32x4 sh = *(const f32x4*)(md2 + col + 4 * q4), sc = *(const f32x4*)(md2 + DM + col + 4 * q4);
                    w8[q4] = pack4_fp8(v[j][4 * q4] * (1.0f + sc[0]) + sh[0], v[j][4 * q4 + 1] * (1.0f + sc[1]) + sh[1], v[j][4 * q4 + 2] * (1.0f + sc[2]) + sh[2], v[j][4 * q4 + 3] * (1.0f + sc[3]) + sh[3]);
                }
                *(u32x4*)(p.U8 + row * DM + col) = w8;
            }
            asm volatile("" ::: "memory");
        }
    }
}

DEV void phase_attn(const Params& p, const int WV, LAS unsigned char* lds) {
    const int TIDX = opaque_tid(WV);
    constexpr int RS = 288;
    LAS unsigned char* Ks = lds; LAS unsigned char* Vs = lds + 256 * RS;
    const int tid = TIDX, wid = tid >> 6, lane = tid & 63, fr = lane & 15, fq = lane >> 4;
    const int qb = wid >> 2, wq = wid & 3;
    const int rq = 64 + 64 * qb + 16 * wq + fr;
    u32x4 kreg[8], vreg[8]; bf16x8 qn[4];
    auto load_unit = [&](int L) {
        const int su = L & 31, pat = (L >> 5) % 3, bh = L / 96, h = bh & 15, b = bh >> 4;
        const int d = pat == 0 ? 1 : (pat == 1 ? 4 : 16), Lr = SEQ / d, npair = Lr / 128, r = su / npair, n2 = su % npair, l0 = 128 * n2 - 64;
#pragma unroll
        for (int it = 0; it < 8; ++it) {
            const int ci = tid + 512 * it, row = ci >> 4, ch = ci & 15;
            int l = l0 + row; l = l < 0 ? 0 : (l > Lr - 1 ? Lr - 1 : l);
            const bf16_t* src = p.qkv + ((long)b * SEQ + (long)l * d + r) * 6144 + h * 128 + ch * 8;
            kreg[it] = *(const u32x4*)(src + 2048); vreg[it] = *(const u32x4*)(src + 4096);
        }
        const long qtok = (long)b * SEQ + (long)(l0 + rq) * d + r;
#pragma unroll
        for (int ks = 0; ks < 4; ++ks) qn[ks] = *(const bf16x8*)(p.qkv + qtok * 6144 + h * 128 + 32 * ks + 8 * fq);
    };
    if ((int)blockIdx.x < 4 * 16 * 3 * 32) load_unit(blockIdx.x);
    for (int L = blockIdx.x; L < 4 * 16 * 3 * 32; L += gridDim.x) {
        const int su = L & 31, pat = (L >> 5) % 3, bh = L / 96, h = bh & 15, b = bh >> 4;
        const int d = pat == 0 ? 1 : (pat == 1 ? 4 : 16), Lr = SEQ / d, npair = Lr / 128;
        const int r = su / npair, n2 = su % npair;
        const int l0 = 128 * n2 - 64;
        const long qtok = (long)b * SEQ + (long)(l0 + rq) * d + r;
#pragma unroll
        for (int it = 0; it < 8; ++it) {
            const int ci = tid + 512 * it, row = ci >> 4, ch = ci & 15;
            *(LAS u32x4*)(Ks + row * RS + ch * 16) = kreg[it]; *(LAS u32x4*)(Vs + row * RS + ch * 16) = vreg[it];
        }
        bf16x8 qf[4];
#pragma unroll
        for (int ks = 0; ks < 4; ++ks) qf[ks] = qn[ks];
        __syncthreads();
        if (L + (int)gridDim.x < 4 * 16 * 3 * 32) load_unit(L + gridDim.x);
        f32x4 s[12];
#pragma unroll
        for (int kt = 0; kt < 12; ++kt) {
            s[kt] = (f32x4){0.f, 0.f, 0.f, 0.f};
#pragma unroll
            for (int ks = 0; ks < 4; ++ks) {
                const bf16x8 kf = *(const LAS bf16x8*)(Ks + (64 * qb + 16 * kt + fr) * RS + ks * 64 + fq * 16);
                s[kt] = __builtin_amdgcn_mfma_f32_16x16x32_bf16(kf, qf[ks], s[kt], 0, 0, 0);
            }
        }
        const float slope = exp2f(-0.5f * (float)(h + 1)) * (float)d * 1.44269504f;
        float mx = -3.0e38f;
        int rkb = 64 * qb + 4 * fq - rq;
        asm volatile("" : "+v"(rkb));
        const float frkb = (float)rkb;
        if (l0 >= 0 && l0 + 256 <= Lr) {
#pragma unroll
            for (int kt = 0; kt < 12; ++kt)
#pragma unroll
                for (int j = 0; j < 4; ++j) {
                    const float x = frkb + (float)(16 * kt + j);
                    const float v = (fabsf(x) <= 64.0f) ? __builtin_fmaf(-slope, fabsf(x), s[kt][j]) : -1.0e30f;
                    s[kt][j] = v; mx = fmaxf(mx, v);
                }
        } else {
            const float flq = (float)(l0 + rq), fLr = (float)Lr;
#pragma unroll
            for (int kt = 0; kt < 12; ++kt)
#pragma unroll
                for (int j = 0; j < 4; ++j) {
                    const float x = frkb + (float)(16 * kt + j), lk = flq + x;
                    const bool valid = (fabsf(x) <= 64.0f) && (lk >= 0.0f) && (lk < fLr);
                    const float v = valid ? __builtin_fmaf(-slope, fabsf(x), s[kt][j]) : -1.0e30f;
                    s[kt][j] = v; mx = fmaxf(mx, v);
                }
        }
        mx = fmaxf(mx, SHFLX(mx, 16)); mx = fmaxf(mx, SHFLX(mx, 32));
        float sum = 0.f;
#pragma unroll
        for (int kt = 0; kt < 12; ++kt)
#pragma unroll
            for (int j = 0; j < 4; ++j) { const float e = __builtin_amdgcn_exp2f(s[kt][j] - mx); s[kt][j] = e; sum += e; }
        sum += SHFLX(sum, 16); sum += SHFLX(sum, 32);
        f32x4 o[8];
#pragma unroll
        for (int dt = 0; dt < 8; ++dt) o[dt] = (f32x4){0.f, 0.f, 0.f, 0.f};
        const int q4 = fr >> 2, p4 = fr & 3;
#pragma unroll
        for (int ks = 0; ks < 6; ++ks) {
            union { bf16x8 v; unsigned w[4]; } pf;
            pf.w[0] = cvt_pk_bf16(s[2 * ks][0], s[2 * ks][1]); pf.w[1] = cvt_pk_bf16(s[2 * ks][2], s[2 * ks][3]);
            pf.w[2] = cvt_pk_bf16(s[2 * ks + 1][0], s[2 * ks + 1][1]); pf.w[3] = cvt_pk_bf16(s[2 * ks + 1][2], s[2 * ks + 1][3]);
            const int krow = 64 * qb + 32 * ks + 4 * fq + q4;
            const unsigned a0 = (unsigned)(size_t)(Vs + krow * RS + 8 * p4);
            u32x2 vh[16];
            asm volatile(
                "ds_read_b64_tr_b16 %0, %16 offset:0\n\tds_read_b64_tr_b16 %1, %16 offset:4608\n\t"
                "ds_read_b64_tr_b16 %2, %16 offset:32\n\tds_read_b64_tr_b16 %3, %16 offset:4640\n\t"
                "ds_read_b64_tr_b16 %4, %16 offset:64\n\tds_read_b64_tr_b16 %5, %16 offset:4672\n\t"
                "ds_read_b64_tr_b16 %6, %16 offset:96\n\tds_read_b64_tr_b16 %7, %16 offset:4704\n\t"
                "ds_read_b64_tr_b16 %8, %16 offset:128\n\tds_read_b64_tr_b16 %9, %16 offset:4736\n\t"
                "ds_read_b64_tr_b16 %10, %16 offset:160\n\tds_read_b64_tr_b16 %11, %16 offset:4768\n\t"
                "ds_read_b64_tr_b16 %12, %16 offset:192\n\tds_read_b64_tr_b16 %13, %16 offset:4800\n\t"
                "ds_read_b64_tr_b16 %14, %16 offset:224\n\tds_read_b64_tr_b16 %15, %16 offset:4832\n\t"
                "s_waitcnt lgkmcnt(0)"
                : "=&v"(vh[0]), "=&v"(vh[1]), "=&v"(vh[2]), "=&v"(vh[3]), "=&v"(vh[4]), "=&v"(vh[5]), "=&v"(vh[6]), "=&v"(vh[7]),
                  "=&v"(vh[8]), "=&v"(vh[9]), "=&v"(vh[10]), "=&v"(vh[11]), "=&v"(vh[12]), "=&v"(vh[13]), "=&v"(vh[14]), "=&v"(vh[15])
                : "v"(a0) : "memory");
#pragma unroll
            for (int dt = 0; dt < 8; ++dt) {
                union { bf16x8 v; u32x2 h[2]; } vf; vf.h[0] = vh[2 * dt]; vf.h[1] = vh[2 * dt + 1];
                o[dt] = __builtin_amdgcn_mfma_f32_16x16x32_bf16(vf.v, pf.v, o[dt], 0, 0, 0);
            }
        }
        const float inv = 1.0f / sum;
        bf16_t* op = p.op + ((long)pat * NTOK + qtok) * DM + h * 128;
#pragma unroll
        for (int dt = 0; dt < 8; ++dt) {
            u32x2 w; w.x = cvt_pk_bf16(o[dt][0] * inv, o[dt][1] * inv); w.y = cvt_pk_bf16(o[dt][2] * inv, o[dt][3] * inv);
            *(u32x2*)(op + 16 * dt + 4 * fq) = w;
        }
        if (fq == 0) p.lse[((long)pat * NTOK + qtok) * 16 + h] = (mx + __log2f(sum)) * 0.69314718f;
        __syncthreads();
    }
}
DEV void phase_merge(const Params& p, const int WV) {
    const int TIDX = opaque_tid(WV);
    const long gtid = (long)blockIdx.x * NTHREADS + TIDX, gsz = (long)gridDim.x * NTHREADS;
    for (long i = gtid; i < (long)NTOK * DM / 8; i += gsz) {
        const long row = i >> 8; const int col = (int)(i & 255) * 8, h = col >> 7;
        const float l0 = p.lse[row * 16 + h], l1 = p.lse[((long)NTOK + row) * 16 + h], l2 = p.lse[(2L * NTOK + row) * 16 + h];
        const float mx = fmaxf(l0, fmaxf(l1, l2)); float w0 = __expf(l0 - mx), w1 = __expf(l1 - mx), w2 = __expf(l2 - mx);
        const float inv = 1.0f / (w0 + w1 + w2); w0 *= inv; w1 *= inv; w2 *= inv;
        float a[8], b[8], c[8], o[8];
        unpack8(*(const u32x4*)(p.op + row * DM + col), a); unpack8(*(const u32x4*)(p.op + ((long)NTOK + row) * DM + col), b); unpack8(*(const u32x4*)(p.op + (2L * NTOK + row) * DM + col), c);
#pragma unroll
        for (int j = 0; j < 8; ++j) o[j] = w0 * a[j] + w1 * b[j] + w2 * c[j];
        *(u32x4*)(p.ocat + row * DM + col) = pack8(o);
    }
}


DEV void phase_attn_naive(const Params& p, const int WV) {
    const int TIDX = opaque_tid(WV);
    const int lane = TIDX & 63; const long gw = (long)blockIdx.x * 8 + __builtin_amdgcn_readfirstlane(TIDX >> 6), nw = (long)gridDim.x * 8;
    for (long it = gw; it < (long)NTOK * 16; it += nw) {
        const long tok = it >> 4; const int h = (int)(it & 15), b = (int)(tok >> 12), t = (int)(tok & 4095);
        const unsigned qw = *(const unsigned*)(p.qkv + tok * 6144 + h * 128 + 2 * lane);
        const float q0 = bflo(qw), q1 = bfhi(qw);
        float m = -3.0e38f, l = 0.f, o0 = 0.f, o1 = 0.f;
        const float slope = exp2f(-0.5f * (float)(h + 1));
        for (int pat = 0; pat < 3; ++pat) {
            const int d = pat == 0 ? 1 : (pat == 1 ? 4 : 16), Lr = SEQ / d, r = t % d, lq = t / d;
            for (int j = -64; j <= 64; ++j) {
                const int lk = lq + j; if (lk < 0 || lk >= Lr) continue;
                const long kt = (long)b * SEQ + (long)lk * d + r;
                const unsigned kw = *(const unsigned*)(p.qkv + kt * 6144 + 2048 + h * 128 + 2 * lane);
                const unsigned vw = *(const unsigned*)(p.qkv + kt * 6144 + 4096 + h * 128 + 2 * lane);
                const float sc = wave_sum(q0 * bflo(kw) + q1 * bfhi(kw)) - slope * (float)(d * (j < 0 ? -j : j));
                const float mn = fmaxf(m, sc), f = __expf(m - mn), pe = __expf(sc - mn);
                l = l * f + pe; o0 = o0 * f + pe * bflo(vw); o1 = o1 * f + pe * bfhi(vw); m = mn;
            }
        }
        *(unsigned*)(p.ocat + tok * DM + h * 128 + 2 * lane) = cvt_pk_bf16(o0 / l, o1 / l);
    }
}


DEV void phase_attn_check(const Params& p, const int WV) {
    const int TIDX = opaque_tid(WV);
    const int lane = TIDX & 63; const long gw = (long)blockIdx.x * 8 + __builtin_amdgcn_readfirstlane(TIDX >> 6), nw = (long)gridDim.x * 8;
    for (long it = gw; it < (long)NTOK * 16; it += nw) {
        const long tok = it >> 4; const int h = (int)(it & 15), b = (int)(tok >> 12), t = (int)(tok & 4095);
        const unsigned qw = *(const unsigned*)(p.qkv + tok * 6144 + h * 128 + 2 * lane);
        const float q0 = bflo(qw), q1 = bfhi(qw);
        const float slope = exp2f(-0.5f * (float)(h + 1));
        for (int pat = 0; pat < 3; ++pat) {
            float m = -3.0e38f, l = 0.f, o0 = 0.f, o1 = 0.f;
            const int d = pat == 0 ? 1 : (pat == 1 ? 4 : 16), Lr = SEQ / d, r = t % d, lq = t / d;
            for (int j = -64; j <= 64; ++j) {
                const int lk = lq + j; if (lk < 0 || lk >= Lr) continue;
                const long kt = (long)b * SEQ + (long)lk * d + r;
                const unsigned kw = *(const unsigned*)(p.qkv + kt * 6144 + 2048 + h * 128 + 2 * lane);
                const unsigned vw = *(const unsigned*)(p.qkv + kt * 6144 + 4096 + h * 128 + 2 * lane);
                const float sc = wave_sum(q0 * bflo(kw) + q1 * bfhi(kw)) - slope * (float)(d * (j < 0 ? -j : j));
                const float mn = fmaxf(m, sc), f = __expf(m - mn), pe = __expf(sc - mn);
                l = l * f + pe; o0 = o0 * f + pe * bflo(vw); o1 = o1 * f + pe * bfhi(vw); m = mn;
            }
            const unsigned ow = *(const unsigned*)(p.op + ((long)pat * NTOK + tok) * DM + h * 128 + 2 * lane);
            const float e0 = fabsf(bflo(ow) - o0 / l), e1 = fabsf(bfhi(ow) - o1 / l);
            const float le = fabsf(p.lse[((long)pat * NTOK + tok) * 16 + h] - (m + __logf(l)));
            const bool bad_o = !(e0 < 0.05f && e1 < 0.05f), bad_l = !(le < 0.05f);
            if (__ballot(bad_o) && lane == 0) atomicOr((unsigned*)p.meta + 8, 1u << pat);
            if (bad_l && lane == 0) atomicOr((unsigned*)p.meta + 8, 8u << pat);
        }
    }
}


DEV void phase_merge_check(const Params& p, const int WV) {
    const int TIDX = opaque_tid(WV);
    const int lane = TIDX & 63; const long gw = (long)blockIdx.x * 8 + __builtin_amdgcn_readfirstlane(TIDX >> 6), nw = (long)gridDim.x * 8;
    for (long it = gw; it < (long)NTOK * 16; it += nw) {
        const long tok = it >> 4; const int h = (int)(it & 15), b = (int)(tok >> 12), t = (int)(tok & 4095);
        const unsigned qw = *(const unsigned*)(p.qkv + tok * 6144 + h * 128 + 2 * lane);
        const float q0 = bflo(qw), q1 = bfhi(qw);
        float m = -3.0e38f, l = 0.f, o0 = 0.f, o1 = 0.f;
        const float slope = exp2f(-0.5f * (float)(h + 1));
        for (int pat = 0; pat < 3; ++pat) {
            const int d = pat == 0 ? 1 : (pat == 1 ? 4 : 16), Lr = SEQ / d, r = t % d, lq = t / d;
            for (int j = -64; j <= 64; ++j) {
                const int lk = lq + j; if (lk < 0 || lk >= Lr) continue;
                const long kt = (long)b * SEQ + (long)lk * d + r;
                const unsigned kw = *(const unsigned*)(p.qkv + kt * 6144 + 2048 + h * 128 + 2 * lane);
                const unsigned vw = *(const unsigned*)(p.qkv + kt * 6144 + 4096 + h * 128 + 2 * lane);
                const float sc = wave_sum(q0 * bflo(kw) + q1 * bfhi(kw)) - slope * (float)(d * (j < 0 ? -j : j));
                const float mn = fmaxf(m, sc), f = __expf(m - mn), pe = __expf(sc - mn);
                l = l * f + pe; o0 = o0 * f + pe * bflo(vw); o1 = o1 * f + pe * bfhi(vw); m = mn;
            }
        }
        const float l0 = p.lse[tok * 16 + h], l1 = p.lse[((long)NTOK + tok) * 16 + h], l2 = p.lse[(2L * NTOK + tok) * 16 + h];
        const float mx = fmaxf(l0, fmaxf(l1, l2)); float w0 = __expf(l0 - mx), w1 = __expf(l1 - mx), w2 = __expf(l2 - mx);
        const float inv = 1.0f / (w0 + w1 + w2); w0 *= inv; w1 *= inv; w2 *= inv;
        const unsigned a = *(const unsigned*)(p.op + tok * DM + h * 128 + 2 * lane), bb = *(const unsigned*)(p.op + ((long)NTOK + tok) * DM + h * 128 + 2 * lane), c = *(const unsigned*)(p.op + (2L * NTOK + tok) * DM + h * 128 + 2 * lane);
        const float m0 = w0 * bflo(a) + w1 * bflo(bb) + w2 * bflo(c), m1 = w0 * bfhi(a) + w1 * bfhi(bb) + w2 * bfhi(c);
        const float e0 = fabsf(m0 - o0 / l), e1 = fabsf(m1 - o1 / l);
        float em = wave_max(fmaxf(e0, e1)); if (!(em < 0.9f)) em = 0.9f;
        if (lane == 0) atomicMax((unsigned*)p.meta + 8, __float_as_uint(em));
    }
}

template <int PH> DEV void run_phase(const Params& p, const int WV, LAS unsigned char* lds) {
    if constexpr (PH == 0) phase_prologue(p, WV, lds);
    if constexpr (PH == 1) phase_modulate(p, WV, p.x, 0);
    if constexpr (PH == 2) { EpiBf16 E{p.proj, INP, 0, 1.0f}; phase_gemm_plain(lds, WV, p.U, DM, p.wt_in, DM, NTOK, INP, DM, INP, E); }
    if constexpr (PH == 3) { phase_fold(p, WV); phase_rwkv_prep(p, WV); }
    if constexpr (PH == 4) { EpiLoraWA E{p.omw, p.iclr, p.ab_w0, p.ab_a0}; phase_gemm_plain(lds, WV, p.alora, 512, p.wl_wa, 256, NTOK, 4096, 256, 0, E);
                             phase_fourier1(p, WV, lds); phase_wn(p, WV);
                             EpiBf16 E2{p.G, 1024, 0, 1.0f}; phase_gemm_plain(lds, WV, p.alora + 256, 512, p.wl_g, 256, NTOK, 1024, 256, 1024, E2); }
    if constexpr (PH == 5) { phase_scan(p, WV, lds); phase_fourier2(p, WV, lds); phase_nyquist(p, WV); }
    if constexpr (PH == 6) { phase_postscan(p, WV); phase_unfold(p, WV); }
    if constexpr (PH == 7) { EpiResid E{p.mod + 0 * 4 * 6144 + 4096, p.T, (DBG_ZERO & 1) ? 0.f : 1.f}; phase_gemm_plain(lds, WV, p.ycat, DM, p.wt_out0, DM, NTOK, DM, DM, DM, E); }
    if constexpr (PH == 8) { if (DBG_DRY & 1) { phase_lnr(p, WV, 0, p.x, lds, true); __syncthreads(); } phase_lnr(p, WV, 0, p.x, lds); }
    if constexpr (PH == 9) phase_place(p, WV, 0, lds);
    if constexpr (PH == 10) phase_moe1(p, WV, 0, lds);
    if constexpr (PH == 11) phase_moe2(p, WV, 0, lds);
    if constexpr (PH == 12) { if (DBG_DRY & 2) phase_combine(p, WV, 0, true); phase_combine(p, WV, 0); }
    if constexpr (PH == 13) { EpiBf16 E{p.qkv, 6144, 2048, 0.08838834764831845f * 1.4426950408889634f};     phase_gemm_plain<1>(lds, WV, (const bf16_t*)p.U8, DM, p.wt_qkv, DM, NTOK, 6144, DM, 6144, E); }
#if DBG_NAIVE_ATTN == 3
    if constexpr (PH == 14) { phase_attn(p, WV, lds); }
    if constexpr (PH == 15) { phase_attn_check(p, WV); phase_attn_naive(p, WV); }
#elif DBG_NAIVE_ATTN == 2
    if constexpr (PH == 14) { phase_attn(p, WV, lds); phase_attn_naive(p, WV); }
    if constexpr (PH == 15) phase_attn_check(p, WV);
#elif DBG_NAIVE_ATTN
    if constexpr (PH == 14) phase_attn_naive(p, WV);
#else
    if constexpr (PH == 14) phase_attn(p, WV, lds);
    if constexpr (PH == 15) phase_merge(p, WV);
#endif
    if constexpr (PH == 16) { EpiResid E{p.mod + 2 * 4 * 6144 + 4096, p.T, (DBG_ZERO & 4) ? 0.f : 1.f}; phase_gemm_plain(lds, WV, p.ocat, DM, p.wt_o1, DM, NTOK, DM, DM, DM, E); }
    if constexpr (PH == 17) phase_lnr(p, WV, 1, nullptr, lds);
    if constexpr (PH == 18) phase_place(p, WV, 1, lds);
    if constexpr (PH == 19) phase_moe1(p, WV, 1, lds);
    if constexpr (PH == 20) phase_moe2(p, WV, 1, lds);
    if constexpr (PH == 21) phase_combine_l1(p, WV, 1);
}
constexpr int NPHASES = 22;

extern __shared__ __attribute__((aligned(16))) unsigned char dyn_lds[];

template <int PH> __global__ void __launch_bounds__(NTHREADS, 2) k_phase(Params p) {
    const int WV = __builtin_amdgcn_readfirstlane(threadIdx.x >> 6);
    run_phase<PH>(p, WV, (LAS unsigned char*)dyn_lds);
}
template <int PH> DEV void run_from(const Params& p, const int WV, LAS unsigned char* lds, const XcdBarrier& bar) {
    if constexpr (PH == 5 && (DBG_DRY & 8) != 0) { phase_scan(p, WV, lds, p.meta[0] >= -5); xcd_barrier(bar); }
    if constexpr (PH == 11 && (DBG_DRY & 4) != 0) { phase_moe2(p, WV, 0, lds, p.meta[0] >= 0); xcd_barrier(bar); }
    run_phase<PH>(p, WV, lds);
    if constexpr ((DBG_REPEAT_MASK >> PH) & 1) { xcd_barrier(bar); run_phase<PH>(p, WV, lds); }
    if constexpr (PH + 1 < NPHASES) { xcd_barrier(bar); run_from<PH + 1>(p, WV, lds, bar); }
}
__global__ void __launch_bounds__(NTHREADS, 2) k_mega(Params p) {
    const int WV = __builtin_amdgcn_readfirstlane(threadIdx.x >> 6);
    LAS unsigned char* lds = (LAS unsigned char*)dyn_lds;
    volatile LAS unsigned* st = (volatile LAS unsigned*)(lds + LDS_BYTES - 16);
    if (threadIdx.x == 0) { st[0] = 0u; st[1] = 0u; st[2] = 0u; st[3] = 0u; }
    __syncthreads();
    const XcdBarrier bar = xcd_barrier_post(p.bar, st);
    run_from<0>(p, WV, lds, bar);
}

template <int PH> static void launch_phase(const Params& p, int grid, hipStream_t stream) {
    static bool attr = false;
    if (!attr) { (void)hipFuncSetAttribute((const void*)k_phase<PH>, hipFuncAttributeMaxDynamicSharedMemorySize, LDS_BYTES); attr = true; }
    hipLaunchKernelGGL(k_phase<PH>, dim3(grid), dim3(NTHREADS), LDS_BYTES, stream, p);
}
template <int PH> static void launch_all(const Params& p, int grid, hipStream_t stream) {
    launch_phase<PH>(p, grid, stream);
    if constexpr (PH + 1 < NPHASES) launch_all<PH + 1>(p, grid, stream);
}

extern "C" void kernel_launch(void* const* d_in, const int* in_sizes, int n_in, void* d_out, int out_size, void* d_ws, size_t ws_size, hipStream_t stream) {
    (void)in_sizes; (void)n_in; (void)out_size;
    Params p{};
    const float** ins = (const float**)&p.x;
    for (int i = 0; i < 34; ++i) ins[i] = (const float*)d_in[i];
    p.out = (float*)d_out;
    size_t off = 0;
    auto take = [&](size_t bytes) { void* r = (char*)d_ws + off; off += (bytes + 255) & ~(size_t)255; return r; };
    p.bar = (unsigned*)take(XCD_BAR_WORDS * 4);
    p.gcnt = (int*)take(128 * 4); p.blockbase = (int*)take(256 * 64 * 4); p.meta = (int*)take(64); p.tile_e = (int*)take((RMAX / 256 + 8) * 4);
    p.sel_e = (int*)take((size_t)NTOK * 8 * 4); p.sel_pos = (int*)take((size_t)NTOK * 8 * 4); p.sel_w = (float*)take((size_t)NTOK * 8 * 4);
    p.row_src = (int*)take((size_t)RMAX * 4); p.row_dst = (int*)take((size_t)RMAX * 4); p.row_g = (float*)take((size_t)RMAX * 4); p.row_rec = (u32x2*)take((size_t)RMAX * 8);
    p.mod = (float*)take(4 * 4 * 6144 * 4);
    p.wt_in = (bf16_t*)take((size_t)INP * DM * 2); p.wt_out0 = (bf16_t*)take((size_t)DM * DM * 2); p.wt_qkv = (bf16_t*)take((size_t)3 * DM * DM * 2); p.wt_o1 = (bf16_t*)take((size_t)DM * DM * 2);
    p.w1 = (unsigned char*)take((size_t)130 * 1024 * DM); p.U8 = (unsigned char*)take((size_t)(NTOK + 256) * DM); p.w2 = (bf16_t*)take((size_t)130 * DM * DEXP * 2);
    p.wl_wa = (bf16_t*)take(4096 * 256 * 2); p.wl_g = (bf16_t*)take(1024 * 256 * 2); p.dft1 = (bf16_t*)take(2 * 256 * 256 * 2); p.dft2 = (bf16_t*)take((size_t)2 * 2048 * 2048 * 2); p.wn = (float*)take(4096 * 4);
    p.U = (bf16_t*)take((size_t)(NTOK + 256) * DM * 2); p.X = (bf16_t*)take((size_t)NTOK * DM * 2);
    p.H = (bf16_t*)take((size_t)RMAX * DEXP * 2); p.T = p.H;
    const size_t big0 = off;
    p.slot = (unsigned char*)take(((size_t)NTOK * 9 + 1) * DM);
    const size_t big_end_slot = off; off = big0;
    p.proj = (bf16_t*)take((size_t)NTOK * INP * 2); p.wtf = (bf16_t*)take((size_t)4 * 1024 * 4096 * 2); p.zf = (bf16_t*)take((size_t)4 * 2 * 2048 * 1024 * 2); p.pq = (bf16_t*)take((size_t)4 * 2 * 2048 * 1024 * 2);
    p.R = (bf16_t*)take((size_t)NTOK * 1024 * 2); p.K = (bf16_t*)take((size_t)NTOK * 1024 * 2); p.V = (bf16_t*)take((size_t)NTOK * 1024 * 2); p.KK = (bf16_t*)take((size_t)NTOK * 1024 * 2);
    p.alora = (bf16_t*)take((size_t)NTOK * 512 * 2); p.omw = (bf16_t*)take((size_t)NTOK * 2048 * 2); p.iclr = (bf16_t*)take((size_t)NTOK * 2048 * 2); p.G = (bf16_t*)take((size_t)NTOK * 1024 * 2);
    p.Y = (bf16_t*)take((size_t)2 * NTOK * 1024 * 2); p.ycat = (bf16_t*)take((size_t)NTOK * DM * 2);
    const size_t big_end_mix0 = off; off = big0;
    p.qkv = (bf16_t*)take((size_t)NTOK * 6144 * 2); p.op = (bf16_t*)take((size_t)3 * NTOK * DM * 2); p.lse = (float*)take((size_t)3 * NTOK * 16 * 4); p.ocat = (bf16_t*)take((size_t)NTOK * DM * 2);
    const size_t big_end_mix1 = off;
    off = big_end_slot > big_end_mix0 ? big_end_slot : big_end_mix0; if (big_end_mix1 > off) off = big_end_mix1;
    if (off > ws_size) fprintf(stderr, "kernel_launch: workspace too small: need %zu have %zu\n", off, ws_size);
    (void)hipMemsetAsync(p.bar, 0, XCD_BAR_WORDS * 4, stream);
#if MK_MULTI
    launch_all<0>(p, 256, stream);
#else
    static int grid = 0;
    if (!grid) {
        int dev = 0, cus = 0, per_cu = 0;
        (void)hipGetDevice(&dev);
        (void)hipDeviceGetAttribute(&cus, hipDeviceAttributeMultiprocessorCount, dev);
        (void)hipFuncSetAttribute((const void*)k_mega, hipFuncAttributeMaxDynamicSharedMemorySize, LDS_BYTES);
        (void)hipOccupancyMaxActiveBlocksPerMultiprocessor(&per_cu, k_mega, NTHREADS, LDS_BYTES);
        grid = cus * (per_cu < 1 ? per_cu : 1);
        if (grid <= 0) { fprintf(stderr, "kernel_launch: occupancy query says 0 blocks per CU\n"); grid = 1; }
    }
    hipLaunchKernelGGL(k_mega, dim3(grid), dim3(NTHREADS), LDS_BYTES, stream, p);
#endif
}
```
